# Optimizing an MI355X kernel written in HIP

```python
import jax
import jax.numpy as jnp
from jax import lax
import numpy as np

D_MODEL = 1024
BATCH = 32
SEQ = 2048
DEPTH = 1

HEAD_DIM = 64
N_HEADS_DIL = 8
DIL_PATTERNS = ((128, 1), (512, 4), (2048, 16))
DIL_BLOCK = 128
N_HEADS_NSA = 8
N_KV_NSA = 2
CMP_STRIDE = 16
CMP_LEN = 2 * CMP_STRIDE
CMP_HIDDEN = 256
SEL_LEN = 64
N_SEL = 8
SEL_QCHUNK = 64
WIN = 512
WIN_BLOCK = 128
ROPE_THETA = 500000.0
ROT_DIM = HEAD_DIM // 4
N_GROUPS = 8
EXPERTS_PER_GROUP = 8
N_EXPERTS = N_GROUPS * EXPERTS_PER_GROUP
TOP_K_INNER = 2
D_FF_EXPERT = 256
EPS = 1e-6
NEG = -1e30
BIG = 1e9
SPLIT_SIZES = (N_HEADS_DIL * HEAD_DIM, N_HEADS_DIL * HEAD_DIM, N_HEADS_DIL * HEAD_DIM,
               N_HEADS_NSA * HEAD_DIM,
               N_KV_NSA * HEAD_DIM, N_KV_NSA * HEAD_DIM, N_KV_NSA * HEAD_DIM,
               N_KV_NSA * HEAD_DIM, N_KV_NSA * HEAD_DIM, N_KV_NSA * HEAD_DIM,
               N_HEADS_NSA * 3)
D_IN = sum(SPLIT_SIZES)
D_MIX = (N_HEADS_DIL + N_HEADS_NSA) * HEAD_DIM

kernel_name = 'hymba_dilated_nsa_hmoe_block'


def rmsnorm(x, g):
    xf = x.astype(jnp.float32)
    y = xf * lax.rsqrt(jnp.mean(xf * xf, axis=-1, keepdims=True) + EPS) * g.astype(jnp.float32)
    return y.astype(x.dtype)


def rope_tables(pos):
    inv_freq = ROPE_THETA ** (-jnp.arange(0, ROT_DIM, 2, dtype=jnp.float32) / ROT_DIM)
    ang = pos.astype(jnp.float32)[:, None] * inv_freq[None, :]
    return jnp.cos(ang), jnp.sin(ang)


def apply_rope(x, cos, sin):
    half = ROT_DIM // 2
    xf = x.astype(jnp.float32)
    x1, x2 = xf[..., :half], xf[..., half:ROT_DIM]
    out = jnp.concatenate([x1 * cos - x2 * sin, x2 * cos + x1 * sin, xf[..., ROT_DIM:]], axis=-1)
    return out.astype(x.dtype)


def banded_attention(q, k, v, max_dist, block):
    B_, G, R, L, hd = q.shape
    n_prev = -(-max_dist // block)
    nb = -(-L // block)
    Lp = nb * block
    span = (n_prev + 1) * block
    qp = jnp.pad(q, ((0, 0), (0, 0), (0, 0), (0, Lp - L), (0, 0)))
    kp = jnp.pad(k, ((0, 0), (0, 0), (n_prev * block, Lp - L), (0, 0)))
    vp = jnp.pad(v, ((0, 0), (0, 0), (n_prev * block, Lp - L), (0, 0)))
    scale = hd ** -0.5

    def one_block(i):
        start = i * block
        qb = lax.dynamic_slice_in_dim(qp, start, block, axis=3)
        kb = lax.dynamic_slice_in_dim(kp, start, span, axis=2)
        vb = lax.dynamic_slice_in_dim(vp, start, span, axis=2)
        qpos = start + jnp.arange(block)
        kpos = start - n_prev * block + jnp.arange(span)
        dist = qpos[:, None] - kpos[None, :]
        mask = (dist >= 0) & (dist <= max_dist) & (kpos[None, :] >= 0)
        s = jnp.einsum('bgrqd,bgkd->bgrqk', qb, kb).astype(jnp.float32) * scale
        s = jnp.where(mask, s, NEG)
        m = jnp.max(s, axis=-1, keepdims=True)
        p = jnp.exp(s - m)
        l = jnp.sum(p, axis=-1, keepdims=True)
        o = jnp.einsum('bgrqk,bgkd->bgrqd', p.astype(vb.dtype), vb).astype(jnp.float32) / l
        return o.astype(q.dtype), (m + jnp.log(l))[..., 0]

    o, lse = lax.map(one_block, jnp.arange(nb))
    o = jnp.moveaxis(o, 0, 3).reshape(B_, G, R, Lp, hd)[:, :, :, :L]
    lse = jnp.moveaxis(lse, 0, 3).reshape(B_, G, R, Lp)[..., :L]
    return o, lse


def dilated_mixer(q, k, v):
    B_, H, S, hd = q.shape
    outs, lses = [], []
    for window, dil in DIL_PATTERNS:
        L = S // dil

        def to_sub(t, L=L, dil=dil):
            return t.reshape(B_, H, L, dil, hd).transpose(0, 1, 3, 2, 4).reshape(B_, H * dil, L, hd)

        o, lse = banded_attention(to_sub(q)[:, :, None], to_sub(k), to_sub(v), window // dil, DIL_BLOCK)
        outs.append(o[:, :, 0].reshape(B_, H, dil, L, hd).transpose(0, 1, 3, 2, 4).reshape(B_, H, S, hd))
        lses.append(lse[:, :, 0].reshape(B_, H, dil, L).transpose(0, 1, 3, 2).reshape(B_, H, S))
    w = jax.nn.softmax(jnp.stack(lses, axis=0), axis=0)
    out = jnp.sum(w[..., None] * jnp.stack(outs, axis=0).astype(jnp.float32), axis=0)
    return out.astype(q.dtype)


def compress_kv(kv, pe, w1, w2):
    B_, S, G, hd = kv.shape
    chunks = kv.reshape(B_, S // CMP_STRIDE, CMP_STRIDE, G, hd)
    blocks = jnp.concatenate([chunks[:, :-1], chunks[:, 1:]], axis=2) + pe[None, None, :, None, :]
    n_c = blocks.shape[1]
    flat = blocks.transpose(0, 1, 3, 2, 4).reshape(B_, n_c, G, CMP_LEN * hd)
    out = jax.nn.gelu(flat @ w1) @ w2
    return out.transpose(0, 2, 1, 3)


def nsa_mixer(q, kc_raw, vc_raw, ks, vs, kw, vw, gate_logits, pe_kc, w_kc1, w_kc2, pe_vc, w_vc1, w_vc2):
    B_, G, R, S, hd = q.shape
    scale = hd ** -0.5
    t = jnp.arange(S)

    n_c = S // CMP_STRIDE - 1
    end_pos = jnp.arange(n_c) * CMP_STRIDE + CMP_LEN - 1
    cos_c, sin_c = rope_tables(end_pos)
    kc = apply_rope(compress_kv(kc_raw, pe_kc, w_kc1, w_kc2), cos_c, sin_c)
    vc = compress_kv(vc_raw, pe_vc, w_vc1, w_vc2)
    cmask = end_pos[None, :] <= t[:, None]
    s = jnp.einsum('bgrsd,bgcd->bgrsc', q, kc).astype(jnp.float32) * scale
    s = jnp.where(cmask, s, NEG)
    m = jnp.max(s, axis=-1, keepdims=True)
    p = jnp.where(cmask, jnp.exp(s - m), 0.0)
    l = jnp.sum(p, axis=-1, keepdims=True)
    p_cmp = p / jnp.where(l > 0, l, 1.0)
    o_cmp = jnp.einsum('bgrsc,bgcd->bgrsd', p_cmp.astype(vc.dtype), vc)

    n_s = S // SEL_LEN
    cs = jnp.arange(n_c) * CMP_STRIDE
    js = jnp.arange(n_s) * SEL_LEN
    overlap = jnp.clip(jnp.minimum(cs[:, None] + CMP_LEN, js[None, :] + SEL_LEN)
                       - jnp.maximum(cs[:, None], js[None, :]), 0, None).astype(jnp.float32) / CMP_LEN
    imp = jnp.einsum('bgrsc,cj->bgsj', p_cmp, overlap)
    j = jnp.arange(n_s)[None, :]
    blk_t = (t // SEL_LEN)[:, None]
    forced = (j == 0) | (j == blk_t) | (j == blk_t - 1)
    valid = j * SEL_LEN <= t[:, None]
    imp = jnp.where(valid, jnp.where(forced, BIG, imp), -BIG)
    k_sel = min(N_SEL, n_s)
    _, idx = lax.top_k(imp, k_sel)

    ks_blocks = ks.reshape(B_, G, n_s, SEL_LEN, hd)
    vs_blocks = vs.reshape(B_, G, n_s, SEL_LEN, hd)
    gather = jax.vmap(jax.vmap(lambda blk, ids: blk[ids]))

    def sel_chunk(c):
        q0 = c * SEL_QCHUNK
        qc = lax.dynamic_slice_in_dim(q, q0, SEL_QCHUNK, axis=3)
        ic = lax.dynamic_slice_in_dim(idx, q0, SEL_QCHUNK, axis=2)
        kb = gather(ks_blocks, ic)
        vb = gather(vs_blocks, ic)
        kpos = ic[..., None] * SEL_LEN + jnp.arange(SEL_LEN)
        qpos = q0 + jnp.arange(SEL_QCHUNK)
        msk = kpos <= qpos[None, None, :, None, None]
        sc = jnp.einsum('bgrqd,bgqkjd->bgrqkj', qc, kb).astype(jnp.float32) * scale
        sc = jnp.where(msk[:, :, None], sc, NEG).reshape(B_, G, R, SEL_QCHUNK, k_sel * SEL_LEN)
        pc = jax.nn.softmax(sc, axis=-1)
        return jnp.einsum('bgrqn,bgqnd->bgrqd', pc.astype(vb.dtype),
                          vb.reshape(B_, G, SEL_QCHUNK, k_sel * SEL_LEN, hd))

    o_sel = lax.map(sel_chunk, jnp.arange(S // SEL_QCHUNK))
    o_sel = jnp.moveaxis(o_sel, 0, 3).reshape(B_, G, R, S, hd)

    o_win, _ = banded_attention(q, kw, vw, WIN - 1, WIN_BLOCK)

    g = jax.nn.sigmoid(gate_logits.astype(jnp.float32)).reshape(B_, S, G, R, 3).transpose(0, 2, 3, 1, 4)
    out = (g[..., 0:1] * o_cmp.astype(jnp.float32) + g[..., 1:2] * o_sel.astype(jnp.float32)
           + g[..., 2:3] * o_win.astype(jnp.float32))
    return out.astype(q.dtype)


def hier_moe(h, w_rg, b_rg, w_re, b_re, w_gate, w_up, w_down):
    T = h.shape[0]
    pg = jax.nn.softmax((h @ w_rg + b_rg).astype(jnp.float32), axis=-1)
    g_star = jnp.argmax(pg, axis=-1)
    p_g = jnp.max(pg, axis=-1, keepdims=True)
    g_onehot = jax.nn.one_hot(g_star, N_GROUPS, dtype=jnp.float32)
    el = (jnp.einsum('td,dge->tge', h, w_re) + b_re).astype(jnp.float32)
    el_sel = jnp.einsum('tge,tg->te', el, g_onehot)
    pe = jax.nn.softmax(el_sel, axis=-1)
    top_v, top_i = lax.top_k(pe, TOP_K_INNER)
    top_w = top_v / jnp.sum(top_v, axis=-1, keepdims=True) * p_g
    inner = jnp.sum(jax.nn.one_hot(top_i, EXPERTS_PER_GROUP, dtype=jnp.float32) * top_w[..., None], axis=1)
    comb = (g_onehot[:, :, None] * inner[:, None, :]).reshape(T, N_EXPERTS)
    y = jnp.zeros((T, h.shape[1]), jnp.float32)
    for e in range(N_EXPERTS):
        he = jax.nn.silu(h @ w_gate[e]) * (h @ w_up[e])
        y = y + comb[:, e:e + 1] * (he @ w_down[e]).astype(jnp.float32)
    return y.astype(h.dtype)


def hybrid_layer(x, cos_t, sin_t, norm1_g, w_in, pe_kc, w_kc1, w_kc2, pe_vc, w_vc1, w_vc2, w_o,
                 norm2_g, w_rg, b_rg, w_re, b_re, w_gate, w_up, w_down):
    B_, S, D = x.shape
    hd = HEAD_DIM
    h = rmsnorm(x, norm1_g)
    proj = h @ w_in
    offsets = [int(o) for o in np.cumsum(SPLIT_SIZES)[:-1]]
    aq, ak, av, bq, kc_raw, vc_raw, ks, vs, kw, vw, gate_logits = jnp.split(proj, offsets, axis=-1)

    def heads(t, n):
        return t.reshape(B_, S, n, hd).transpose(0, 2, 1, 3)

    o_a = dilated_mixer(apply_rope(heads(aq, N_HEADS_DIL), cos_t, sin_t),
                        apply_rope(heads(ak, N_HEADS_DIL), cos_t, sin_t),
                        heads(av, N_HEADS_DIL))
    R = N_HEADS_NSA // N_KV_NSA
    qb = apply_rope(bq.reshape(B_, S, N_KV_NSA, R, hd).transpose(0, 2, 3, 1, 4), cos_t, sin_t)
    o_b = nsa_mixer(qb, kc_raw.reshape(B_, S, N_KV_NSA, hd), vc_raw.reshape(B_, S, N_KV_NSA, hd),
                    apply_rope(heads(ks, N_KV_NSA), cos_t, sin_t), heads(vs, N_KV_NSA),
                    apply_rope(heads(kw, N_KV_NSA), cos_t, sin_t), heads(vw, N_KV_NSA),
                    gate_logits, pe_kc, w_kc1, w_kc2, pe_vc, w_vc1, w_vc2)
    mix = jnp.concatenate([o_a.transpose(0, 2, 1, 3).reshape(B_, S, -1),
                           o_b.transpose(0, 3, 1, 2, 4).reshape(B_, S, -1)], axis=-1)
    x = x + mix @ w_o
    h2 = rmsnorm(x, norm2_g).reshape(B_ * S, D)
    return x + hier_moe(h2, w_rg, b_rg, w_re, b_re, w_gate, w_up, w_down).reshape(B_, S, D)


def setup_inputs(seed: int = 0) -> dict:
    key = jax.random.key(seed)
    ks = jax.random.split(key, 20)
    f32 = jnp.float32

    def nrm(k, shape, fan_in):
        return jax.random.normal(k, shape, f32) * fan_in ** -0.5

    return {
        'x': jax.random.normal(ks[0], (BATCH, SEQ, D_MODEL), f32),
        'norm1_g': 1.0 + 0.02 * jax.random.normal(ks[1], (DEPTH, D_MODEL), f32),
        'w_in': nrm(ks[2], (DEPTH, D_MODEL, D_IN), D_MODEL),
        'pe_kc': 0.1 * jax.random.normal(ks[3], (DEPTH, CMP_LEN, HEAD_DIM), f32),
        'w_kc1': nrm(ks[4], (DEPTH, CMP_LEN * HEAD_DIM, CMP_HIDDEN), CMP_LEN * HEAD_DIM),
        'w_kc2': nrm(ks[5], (DEPTH, CMP_HIDDEN, HEAD_DIM), CMP_HIDDEN),
        'pe_vc': 0.1 * jax.random.normal(ks[6], (DEPTH, CMP_LEN, HEAD_DIM), f32),
        'w_vc1': nrm(ks[7], (DEPTH, CMP_LEN * HEAD_DIM, CMP_HIDDEN), CMP_LEN * HEAD_DIM),
        'w_vc2': nrm(ks[8], (DEPTH, CMP_HIDDEN, HEAD_DIM), CMP_HIDDEN),
        'w_o': nrm(ks[9], (DEPTH, D_MIX, D_MODEL), D_MIX),
        'norm2_g': 1.0 + 0.02 * jax.random.normal(ks[10], (DEPTH, D_MODEL), f32),
        'w_rg': nrm(ks[11], (DEPTH, D_MODEL, N_GROUPS), D_MODEL),
        'b_rg': 0.01 * jax.random.normal(ks[12], (DEPTH, N_GROUPS), f32),
        'w_re': nrm(ks[13], (DEPTH, D_MODEL, N_GROUPS, EXPERTS_PER_GROUP), D_MODEL),
        'b_re': 0.01 * jax.random.normal(ks[14], (DEPTH, N_GROUPS, EXPERTS_PER_GROUP), f32),
        'w_gate': nrm(ks[15], (DEPTH, N_EXPERTS, D_MODEL, D_FF_EXPERT), D_MODEL),
        'w_up': nrm(ks[16], (DEPTH, N_EXPERTS, D_MODEL, D_FF_EXPERT), D_MODEL),
        'w_down': nrm(ks[17], (DEPTH, N_EXPERTS, D_FF_EXPERT, D_MODEL), D_FF_EXPERT),
        'norm_f_g': 1.0 + 0.02 * jax.random.normal(ks[18], (D_MODEL,), f32),
    }


def reference(x, norm1_g, w_in, pe_kc, w_kc1, w_kc2, pe_vc, w_vc1, w_vc2, w_o, norm2_g,
              w_rg, b_rg, w_re, b_re, w_gate, w_up, w_down, norm_f_g):
    S = x.shape[1]
    cos_t, sin_t = rope_tables(jnp.arange(S))
    for l in range(DEPTH):
        x = hybrid_layer(x, cos_t, sin_t, norm1_g[l], w_in[l], pe_kc[l], w_kc1[l], w_kc2[l],
                         pe_vc[l], w_vc1[l], w_vc2[l], w_o[l], norm2_g[l], w_rg[l], b_rg[l],
                         w_re[l], b_re[l], w_gate[l], w_up[l], w_down[l])
    return rmsnorm(x, norm_f_g)
```

```cpp
#include <hip/hip_runtime.h>
#include <stdint.h>
#include <math.h>

#ifndef EN_DIL
#define EN_DIL 1
#endif
#ifndef EN_NSA
#define EN_NSA 1
#endif
#ifndef EN_MOE
#define EN_MOE 1
#endif
#ifndef DBG_T1
#define DBG_T1 0
#endif
#ifndef DBG_T2
#define DBG_T2 0
#endif
#ifndef DBG_T3
#define DBG_T3 0
#endif
#ifndef DBG_T4
#define DBG_T4 0
#endif
#ifndef DBG_T5
#define DBG_T5 0
#endif
#ifndef DBG_T6
#define DBG_T6 0
#endif
#ifndef DBG_T8
#define DBG_T8 0
#endif
#ifndef GEMM_SAFE
#define GEMM_SAFE 0
#endif
#ifndef DBG_T9
#define DBG_T9 0
#endif
#ifndef DBG_TA
#define DBG_TA 0
#endif
#ifndef REP_PHASE
#define REP_PHASE -1
#endif
#define REPS(k) for (int rep_ = 0; rep_ < ((REP_PHASE == (k)) ? 2 : 1); ++rep_)
#ifndef DBG_LDSPOISON
#define DBG_LDSPOISON 0
#endif
#ifndef DBG_XBAR
#define DBG_XBAR 0
#endif
#ifndef SKEL
#define SKEL 0
#endif

#define DEV __device__ __forceinline__
#define LDS __attribute__((address_space(3)))
typedef LDS unsigned char* LDSP;
typedef unsigned short bf16_t;
typedef short bf16x8 __attribute__((ext_vector_type(8)));
typedef short s16x4 __attribute__((ext_vector_type(4)));
typedef float f32x16 __attribute__((ext_vector_type(16)));
typedef float f32x4 __attribute__((ext_vector_type(4)));
typedef unsigned u32x4 __attribute__((ext_vector_type(4)));
typedef unsigned u32x2 __attribute__((ext_vector_type(2)));
typedef float f32x2 __attribute__((ext_vector_type(2)));

#define MFMA32(a, b, c) __builtin_amdgcn_mfma_f32_32x32x16_bf16(a, b, c, 0, 0, 0)

constexpr int T_TOK = 65536, SEQ = 2048, DM = 1024;
constexpr int NPROJ = 2840, NPAD = 3072;
constexpr float SCQ = 0.125f * 1.4426950408889634f;
constexpr float EPSN = 1e-6f;

constexpr size_t MB = 1048576;
constexpr size_t OFF_BAR = 0, OFF_QUEUE = 28672, OFF_CNT = 20480, OFF_BIAS1 = 24576, CTL_ZERO = 32768;
constexpr size_t OFF_ROPEC = 1 * MB, OFF_ROPES = 1 * MB + 65536;
constexpr size_t OFF_SEL = 1 * MB + 131072;
constexpr size_t OFF_WINT = 2 * MB;
constexpr size_t OFF_WOT = OFF_WINT + (size_t)NPAD * 1024 * 2;
constexpr size_t OFF_WC1T = OFF_WOT + (size_t)1024 * 1024 * 2;
constexpr size_t OFF_WC2T = OFF_WC1T + (size_t)2 * 256 * 2048 * 2;
constexpr size_t OFF_WRT = OFF_WC2T + (size_t)2 * 256 * 256 * 2;
constexpr size_t OFF_WGUT = OFF_WRT + (size_t)2 * 128 * 1024 * 2;
constexpr size_t OFF_WDT = OFF_WGUT + (size_t)64 * 512 * 1024 * 2;
constexpr size_t OFF_LIST = OFF_WDT + (size_t)64 * 1024 * 256 * 2;
constexpr size_t OFF_TE = OFF_LIST + (size_t)64 * 65536 * 4;
constexpr size_t OFF_TP = OFF_TE + (size_t)T_TOK * 2 * 4;
constexpr size_t OFF_TW = OFF_TP + (size_t)T_TOK * 2 * 4;
constexpr size_t OFF_RSTD2 = OFF_TW + (size_t)T_TOK * 2 * 4;
constexpr size_t OFF_WEND = OFF_RSTD2 + (size_t)T_TOK * 4;
constexpr size_t OFF_R1 = 136 * MB;
constexpr size_t OFF_R2 = 264 * MB;
constexpr size_t OFF_QA = OFF_R2, OFF_KA = OFF_R2 + 64 * MB, OFF_VA = OFF_R2 + 128 * MB, OFF_QB = OFF_R2 + 192 * MB;
constexpr size_t OFF_KV6 = OFF_R2 + 256 * MB;
constexpr size_t OFF_GATE = OFF_R2 + 352 * MB;
constexpr size_t OFF_R3 = 622 * MB;
constexpr size_t OFF_OP = OFF_R3;
constexpr size_t OFF_LSE = OFF_R3 + 192 * MB;
constexpr size_t OFF_HID = OFF_R3 + 198 * MB;
constexpr size_t OFF_KC = OFF_R3 + 206 * MB;
constexpr size_t OFF_VC = OFF_R3 + 207 * MB;
constexpr size_t OFF_X1B = OFF_R2, OFF_X1L = OFF_R2 + 128 * MB;
constexpr size_t OFF_HE = OFF_R1;
constexpr size_t OFF_Y = OFF_R2 + 256 * MB;
static_assert(OFF_WEND <= OFF_R1, "weights region overflow");
static_assert(OFF_Y + (size_t)147456 * 1024 * 2 <= OFF_HID, "Y overlaps live data");

constexpr int LDS_GEMM = 131072;
constexpr int LDS_TB = LDS_GEMM;
constexpr int LDS_TOTAL = LDS_GEMM + 4096;

struct Params {
    const float* x; const float* norm1_g; const float* w_in; const float* pe_kc; const float* w_kc1; const float* w_kc2;
    const float* pe_vc; const float* w_vc1; const float* w_vc2; const float* w_o; const float* norm2_g;
    const float* w_rg; const float* b_rg; const float* w_re; const float* b_re; const float* w_gate; const float* w_up; const float* w_down; const float* norm_f_g;
    float* out; unsigned char* ws;
};

typedef __bf16 bf16v2 __attribute__((ext_vector_type(2)));
DEV unsigned cvt_pk(float lo, float hi) { bf16v2 v; v.x = (__bf16)lo; v.y = (__bf16)hi; return __builtin_bit_cast(unsigned, v); }
DEV float bf_lo(unsigned u) { return __uint_as_float(u << 16); }
DEV float bf_hi(unsigned u) { return __uint_as_float(u & 0xffff0000u); }
DEV float fexp2(float x) { return __builtin_amdgcn_exp2f(x); }
DEV int perm32(int rho) { const int g = rho >> 3, h = (rho >> 2) & 1, e = rho & 3; return 16 * (g >> 1) + 8 * h + 4 * (g & 1) + e; }
DEV int rope_src(int i) { return i < 16 ? ((i & 1) ? 8 + (i >> 1) : (i >> 1)) : i; }
DEV float xhalf_max(float v) { auto r = __builtin_amdgcn_permlane32_swap(__float_as_uint(v), __float_as_uint(v), false, false); return fmaxf(__uint_as_float(r[0]), __uint_as_float(r[1])); }
DEV float xhalf_sum(float v) { auto r = __builtin_amdgcn_permlane32_swap(__float_as_uint(v), __float_as_uint(v), false, false); return __uint_as_float(r[0]) + __uint_as_float(r[1]); }
DEV int opaque(int v) { asm volatile("" : "+v"(v)); return v; }
DEV int lds_off(int row, int chunk) { return row * 128 + ((chunk ^ ((row >> 1) & 7)) << 4); }

#define XB_TMO      128
#define XB_XCNT(j)  (256  + 64 * (j))
#define XB_XSUB(j)  (1280 + 64 * (j))
#define XB_XGEN(j)  (2304 + 64 * (j))
#define XB_TOP      3328
#define XB_TOPGEN   3392
#define XCD_BAR_WORDS 3456
#define XB_SPIN_CAP (1u << 18)
#define LAS __attribute__((address_space(3)))

__device__ __forceinline__ unsigned xb_ld(unsigned* p)              { return __hip_atomic_load(p, __ATOMIC_RELAXED, __HIP_MEMORY_SCOPE_AGENT); }
__device__ __forceinline__ unsigned xb_add(unsigned* p, unsigned v) { return __hip_atomic_fetch_add(p, v, __ATOMIC_RELAXED, __HIP_MEMORY_SCOPE_AGENT); }
__device__ __forceinline__ unsigned xb_xcc_id() { return (unsigned)__builtin_amdgcn_s_getreg((3 << 11) | 20) & 0xFu; }
#define XB_SPIN(cond, bar) do { unsigned _sp = 0; while (cond) { __builtin_amdgcn_s_sleep(1); \
    if ((++_sp & 255u) == 0u) { if (xb_ld(&(bar)[XB_TMO])) break; if (_sp > XB_SPIN_CAP) { atomicAdd(&(bar)[XB_TMO], 1u); break; } } } } while (0)

struct XcdBarrier { unsigned* bar; unsigned x; volatile LAS unsigned* st; };

__device__ __forceinline__ XcdBarrier xcd_barrier_post(unsigned* bar, volatile LAS unsigned* st) {
    XcdBarrier b; b.bar = bar; b.x = xb_xcc_id(); b.st = st;
    if (threadIdx.x == 0) (void)xb_add(&bar[XB_XCNT(b.x)], 1u);
    return b;
}
__device__ __forceinline__ void xcd_barrier_complete(unsigned* bar, unsigned x, unsigned& nloc, unsigned& nx) {
    const unsigned G = gridDim.x * gridDim.y * gridDim.z;
    unsigned sum, cnt, mine, sp = 0u;
    for (;;) {
        sum = 0u; cnt = 0u; mine = 0u;
#pragma unroll
        for (unsigned j = 0; j < 16; ++j) { const unsigned c = xb_ld(&bar[XB_XCNT(j)]); sum += c; cnt += (c > 0u) ? 1u : 0u; mine = (j == x) ? c : mine; }
        if (sum == G) break;
        __builtin_amdgcn_s_sleep(1);
        if ((++sp & 255u) == 0u) { if (xb_ld(&bar[XB_TMO])) break; if (sp > XB_SPIN_CAP) { atomicAdd(&bar[XB_TMO], 1u); break; } }
    }
    nloc = mine > 0u ? mine : 1u; nx = cnt > 0u ? cnt : 1u;
}
__device__ __forceinline__ void xcd_barrier_impl(const XcdBarrier& b) {
    asm volatile("s_waitcnt vmcnt(0)" ::: "memory");
    __syncthreads();
    if (threadIdx.x == 0) {
        unsigned* bar = b.bar;
        __builtin_amdgcn_s_waitcnt(0);
        unsigned nloc = b.st[0], nx = b.st[1];
        if (nloc == 0u) { xcd_barrier_complete(bar, b.x, nloc, nx); b.st[0] = nloc; b.st[1] = nx; }
        const unsigned old = xb_add(&bar[XB_XSUB(b.x)], 1u);
        const unsigned gen = old / nloc;
        if (old + 1u == (gen + 1u) * nloc) {
            __builtin_amdgcn_fence(__ATOMIC_RELEASE, "agent");
            asm volatile("s_waitcnt vmcnt(0)" ::: "memory");
            const unsigned og = xb_add(&bar[XB_TOP], 1u);
            const unsigned tg = og / nx;
            if (og + 1u == (tg + 1u) * nx) xb_add(&bar[XB_TOPGEN], 1u);
            else XB_SPIN(xb_ld(&bar[XB_TOPGEN]) == tg, bar);
            __builtin_amdgcn_fence(__ATOMIC_ACQUIRE, "agent");
            xb_add(&bar[XB_XGEN(b.x)], 1u);
            asm volatile("s_waitcnt vmcnt(0)" ::: "memory");
        } else {
            XB_SPIN(xb_ld(&bar[XB_XGEN(b.x)]) == gen, bar);
            __builtin_amdgcn_fence(__ATOMIC_ACQUIRE, "agent");
            asm volatile("s_waitcnt vmcnt(0)" ::: "memory");
        }
    }
    __syncthreads();
}

DEV void xcd_barrier(unsigned* barw, volatile LAS unsigned* st) { XcdBarrier b; b.bar = barw; b.x = xb_xcc_id(); b.st = st; xcd_barrier_impl(b); }

template <class F>
DEV void tr_matrix(const F f, bf16_t* dst, int NR, int K, int lomode, LDSP lds) {
    LDS float* tile = (LDS float*)lds;
    const int tid = threadIdx.x, tk = K >> 6, nt = (NR >> 6) * tk, G = gridDim.x;
    const int kq = tid >> 6, nn0 = tid & 63;
    float r[8];
    int t = blockIdx.x;
    if (t < nt) { const int n0 = (t / tk) << 6, k0 = (t % tk) << 6;
#pragma unroll
        for (int i = 0; i < 8; ++i) r[i] = f(n0 + nn0, k0 + kq + 8 * i); }
    for (; t < nt; t += G) {
        const int n0 = (t / tk) << 6, k0 = (t % tk) << 6;
#pragma unroll
        for (int i = 0; i < 8; ++i) tile[(kq + 8 * i) * 65 + nn0] = r[i];
        { const int tn = t + G; if (tn < nt) { const int n1 = (tn / tk) << 6, k1 = (tn % tk) << 6;
#pragma unroll
            for (int i = 0; i < 8; ++i) r[i] = f(n1 + nn0, k1 + kq + 8 * i); } }
        __syncthreads();
        {
            const int nn = tid >> 3, k8 = (tid & 7) * 8; float v[8];
#pragma unroll
            for (int j = 0; j < 8; ++j) { v[j] = tile[(k8 + j) * 65 + nn]; if (lomode) v[j] = v[j] - bf_lo(cvt_pk(v[j], 0.f) & 0xffffu); }
            u32x4 w; w.x = cvt_pk(v[0], v[1]); w.y = cvt_pk(v[2], v[3]); w.z = cvt_pk(v[4], v[5]); w.w = cvt_pk(v[6], v[7]);
            *(u32x4*)(dst + (size_t)(n0 + nn) * K + k0 + k8) = w;
        }
        __syncthreads();
    }
}
struct SrcWin { const float* w; const float* g1;
    DEV float operator()(int R, int k) const {
        const int c = R;
        if (c >= NPROJ) return 0.f;
        const bool rp = (c < 1024) || (c >= 1536 && c < 2048) || (c >= 2304 && c < 2432) || (c >= 2560 && c < 2688);
        const int src = rp ? (c & ~63) + rope_src(c & 63) : c;
        const float sc = (c < 512 || (c >= 1536 && c < 2048)) ? SCQ : 1.f;
        return w[(size_t)k * NPROJ + src] * g1[k] * sc; } };
struct SrcWo { const float* w; DEV float operator()(int R, int k) const { return w[(size_t)k * 1024 + R]; } };
DEV const float* psel(const float* a, const float* b, int pick_b) { return (const float*)((uintptr_t)a + (pick_b ? ((uintptr_t)b - (uintptr_t)a) : (uintptr_t)0)); }
struct SrcWc1 { const float* wk; const float* wv; DEV float operator()(int R, int k) const { const float* w = psel(wk, wv, R >> 8); const int r = R & 255; return w[(size_t)k * 256 + r]; } };
struct SrcWc2 { const float* wk; const float* wv;
    DEV float operator()(int R, int k) const { const int kv = R >> 8, r = R & 255, c = r; if (c >= 64) return 0.f;
        return psel(wk, wv, kv)[(size_t)k * 64 + (kv ? c : rope_src(c))]; } };
struct SrcWr { const float* wrg; const float* wre; const float* g2;
    DEV float operator()(int R, int k) const { if (R >= 96) return 0.f; const int c = (R & ~31) + perm32(R & 31), lb = c >> 3, ix = c & 7;
        if (lb > 8) return 0.f; const size_t off = lb == 0 ? (size_t)k * 8 + ix : (size_t)k * 64 + (lb - 1) * 8 + ix; return psel(wrg, wre, lb != 0)[off] * g2[k]; } };
struct SrcWgu { const float* wg; const float* wu; const float* g2;
    DEV float operator()(int R, int k) const { const int e = R >> 9, r = R & 511, pn = r >> 8, bj = (r >> 7) & 1, j = pn * 128 + (r & 127);
        const float* w = psel(wg, wu, bj); return w[((size_t)e * 1024 + k) * 256 + j] * g2[k]; } };
struct SrcWd { const float* w; DEV float operator()(int R, int k) const { const int e = R >> 10, r = R & 1023; return w[((size_t)e * 256 + k) * 1024 + r]; } };

DEV void p0_prologue(const Params& p, LDSP lds) {
    unsigned char* ws = p.ws;
    const int tid = threadIdx.x, lane = tid & 63, wid = tid >> 6, bid = blockIdx.x;
    { const int idx = bid * 512 + tid; if (idx < 2048 * 8) { const int pos = idx >> 3, pp = idx & 7;
        const float invf = (float)pow(500000.0, -(double)pp / 8.0); const float ang = (float)pos * invf;
        ((float*)(ws + OFF_ROPEC))[idx] = (float)cos((double)ang); ((float*)(ws + OFF_ROPES))[idx] = (float)sin((double)ang); } }
    if (bid < 16) { const int kv = bid & 1, jb = (bid >> 1) * 32, j = jb + (tid & 31), part = tid >> 5; const float* pe = psel(p.pe_kc, p.pe_vc, kv); const float* w1 = psel(p.w_kc1, p.w_vc1, kv);
        float a = 0.f; const int k0 = part * 128;
        for (int kk = k0; kk < k0 + 128; ++kk) a += pe[kk] * w1[(size_t)kk * 256 + j];
        LDS float* red = (LDS float*)lds; red[part * 32 + (tid & 31)] = a;
        __syncthreads();
        if (tid < 32) { float t = 0.f; for (int q = 0; q < 16; ++q) t += red[q * 32 + tid]; ((float*)(ws + OFF_BIAS1))[kv * 256 + jb + tid] = t; }
        __syncthreads(); }
    { bf16_t* HB = (bf16_t*)(ws + OFF_R1);
      for (int row = bid * 8 + wid; row < T_TOK; row += 8192) {
        f32x4 v[4][4]; float ss[4];
#pragma unroll
        for (int j = 0; j < 4; ++j) { const float* xr = p.x + (size_t)(row + 2048 * j) * 1024;
#pragma unroll
          for (int i = 0; i < 4; ++i) v[j][i] = *(const f32x4*)(xr + i * 256 + lane * 4); }
#pragma unroll
        for (int j = 0; j < 4; ++j) { ss[j] = 0.f;
#pragma unroll
          for (int i = 0; i < 4; ++i) ss[j] += v[j][i][0] * v[j][i][0] + v[j][i][1] * v[j][i][1] + v[j][i][2] * v[j][i][2] + v[j][i][3] * v[j][i][3]; }
#pragma unroll
        for (int o = 32; o > 0; o >>= 1) {
#pragma unroll
          for (int j = 0; j < 4; ++j) ss[j] += __shfl_xor(ss[j], o); }
#pragma unroll
        for (int j = 0; j < 4; ++j) { const float rs = 1.0f / sqrtf(ss[j] * (1.0f / 1024.0f) + EPSN);
#pragma unroll
          for (int i = 0; i < 4; ++i) { u32x2 w; w.x = cvt_pk(v[j][i][0] * rs, v[j][i][1] * rs); w.y = cvt_pk(v[j][i][2] * rs, v[j][i][3] * rs); *(u32x2*)(HB + (size_t)(row + 2048 * j) * 1024 + i * 256 + lane * 4) = w; } }
      } }
    tr_matrix(SrcWin{p.w_in, p.norm1_g}, (bf16_t*)(ws + OFF_WINT), NPAD, 1024, 0, lds);
    tr_matrix(SrcWo{p.w_o}, (bf16_t*)(ws + OFF_WOT), 1024, 1024, 0, lds);
    tr_matrix(SrcWc1{p.w_kc1, p.w_vc1}, (bf16_t*)(ws + OFF_WC1T), 512, 2048, 0, lds);
    tr_matrix(SrcWc2{p.w_kc2, p.w_vc2}, (bf16_t*)(ws + OFF_WC2T), 512, 256, 0, lds);
    tr_matrix(SrcWr{p.w_rg, p.w_re, p.norm2_g}, (bf16_t*)(ws + OFF_WRT), 128, 1024, 0, lds);
    tr_matrix(SrcWr{p.w_rg, p.w_re, p.norm2_g}, (bf16_t*)(ws + OFF_WRT) + 128 * 1024, 128, 1024, 1, lds);
    tr_matrix(SrcWgu{p.w_gate, p.w_up, p.norm2_g}, (bf16_t*)(ws + OFF_WGUT), 64 * 512, 1024, 0, lds);
    tr_matrix(SrcWd{p.w_down}, (bf16_t*)(ws + OFF_WDT), 64 * 1024, 256, 0, lds);
}

#define GLDS16(src, dstoff) __builtin_amdgcn_global_load_lds((const unsigned*)(src), (LDS unsigned*)(lds + (dstoff)), 16, 0, 0)
namespace pg {
constexpr int BM = 256, BK = 64, HALF = 128, HTB = HALF * BK * 2, STAGE_BYTES = 8 * HTB;
DEV int lds_byte(int r, int c) { const int st = (r >> 4) * 2 + (c >> 5), rr = r & 15, cc = c & 31, ob = rr * 64 + cc * 2; return st * 1024 + (ob ^ (((ob >> 9) & 1) << 5)); }
DEV void stage_rc(int b, int& R, int& C) { const int st = b / 1024, sb = b % 1024, swz = sb ^ (((sb >> 9) & 1) << 5); R = (st >> 1) * 16 + swz / 64; C = (st & 1) * 32 + (swz % 64) / 2; }
DEV int pg_perm32(int rho) { const int n = rho >> 4, i = rho & 15; return 8 * (i >> 2) + 4 * n + (i & 3); }
struct Unit { const char* a; const char* b; int pm, pn, x0, x1, x2; };
typedef f32x4 Acc[2][2][4][2];

template <class Epi, class Sched, bool ALIGN_EPI, bool GATHER>
DEV void gemm_phase(LDSP lds, int K_, int lda, const Sched& S, const Epi& E) {
    int K = K_; asm volatile("" : "+s"(K));
    const int tid = opaque((int)threadIdx.x), wid = __builtin_amdgcn_readfirstlane(tid >> 6), lane = tid & 63, wr = wid >> 2, wc = wid & 3, fr = lane & 15, fq = lane >> 4;
    const int nt = K / BK;
    Unit cur, nxt; int ui = 0;
    if (!S.next(0, cur)) return;
    unsigned voffA0[2], voffA1[2], voffB[2], nvA0[2], nvA1[2]; int sR[2], sC[2];
#pragma unroll
    for (int i = 0; i < 2; ++i) { int R, C; stage_rc(tid * 16 + i * 8192, R, C); sR[i] = R; sC[i] = C; const int Rb = (R & ~31) + pg_perm32(R & 31);
        if constexpr (GATHER) { voffA0[i] = (S.arow(cur, R) + (unsigned)C) * 2u; voffA1[i] = (S.arow(cur, R + HALF) + (unsigned)C) * 2u; }
        else { voffA0[i] = (unsigned)(R * lda + C) * 2u; voffA1[i] = (unsigned)((R + HALF) * lda + C) * 2u; }
        nvA0[i] = voffA0[i]; nvA1[i] = voffA1[i];
        voffB[i] = (unsigned)(Rb * K + C) * 2u; }
    const size_t kstep = (size_t)(BK * 2);
    const size_t hstepB = (size_t)HALF * K * 2;
    const unsigned ldsw = (unsigned)wid * 1024u;
    const int aoff = lds_byte(wr * 64 + fr, fq * 8), boff = lds_byte(wc * 32 + fr, fq * 8);
#define PG_SA(b, h) (((b) * 2 + (h)) * HTB)
#define PG_SB(b, h) ((4 + (b) * 2 + (h)) * HTB)
#define PG_STAGE(bufoff, gbase, voff) do { _Pragma("unroll") for (int _i = 0; _i < 2; ++_i) GLDS16((const char*)(gbase) + (voff)[_i], (bufoff) + ldsw + _i * 8192); } while (0)
#define PG_LDA(dst, b, h) do { _Pragma("unroll") for (int m = 0; m < 4; ++m) _Pragma("unroll") for (int k = 0; k < 2; ++k) dst[m][k] = *(const LDS bf16x8*)(lds + PG_SA(b, h) + aoff + m * 2048 + k * 1024); } while (0)
#define PG_LDB(dst, b, h) do { _Pragma("unroll") for (int n = 0; n < 2; ++n) _Pragma("unroll") for (int k = 0; k < 2; ++k) dst[n][k] = *(const LDS bf16x8*)(lds + PG_SB(b, h) + boff + n * 2048 + k * 1024); } while (0)
#define PG_MMA(ai, bj, At, Bt) do { __builtin_amdgcn_s_setprio(1); _Pragma("unroll") for (int m = 0; m < 4; ++m) _Pragma("unroll") for (int n = 0; n < 2; ++n) _Pragma("unroll") for (int k = 0; k < 2; ++k) \
        acc[ai][bj][m][n] = __builtin_amdgcn_mfma_f32_16x16x32_bf16(Bt[n][k], At[m][k], acc[ai][bj][m][n], 0, 0, 0); __builtin_amdgcn_s_setprio(0); } while (0)
#define PG_WAIT_V(n) asm volatile("s_waitcnt vmcnt(" #n ")" ::: "memory")
#define PG_WAIT_L(n) asm volatile("s_waitcnt lgkmcnt(" #n ")" ::: "memory")
#define PG_BAR __builtin_amdgcn_s_barrier()
#define PG_SCHED __builtin_amdgcn_sched_barrier(0)
    Acc acc;
#pragma unroll
    for (int a = 0; a < 2; ++a)
#pragma unroll
        for (int b = 0; b < 2; ++b)
#pragma unroll
            for (int m = 0; m < 4; ++m)
#pragma unroll
                for (int n = 0; n < 2; ++n) acc[a][b][m][n] = (f32x4){0.f, 0.f, 0.f, 0.f};
    bf16x8 At[4][2], B0[2][2], B1[2][2];
    const char* cA = cur.a; const char* cB = cur.b;
    PG_STAGE(PG_SB(0, 0), cB, voffB); PG_STAGE(PG_SB(0, 1), cB + hstepB, voffB); PG_STAGE(PG_SA(0, 0), cA, voffA0); PG_STAGE(PG_SA(0, 1), cA, voffA1);
    if (wr == 1) PG_BAR;
    PG_WAIT_V(2); PG_BAR;
    PG_STAGE(PG_SB(1, 0), cB + kstep, voffB); PG_STAGE(PG_SA(1, 0), cA + kstep, voffA0); PG_STAGE(PG_SB(1, 1), cB + hstepB + kstep, voffB);
    PG_WAIT_V(6); PG_BAR;
    for (;;) {
        const bool has_next = S.next(ui + 1, nxt);
        const char* nA = has_next ? nxt.a : cA; const char* nB = has_next ? nxt.b : cB;
        if constexpr (GATHER) { if (has_next) {
#pragma unroll
            for (int i = 0; i < 2; ++i) { nvA0[i] = (S.arow(nxt, sR[i]) + (unsigned)sC[i]) * 2u; nvA1[i] = (S.arow(nxt, sR[i] + HALF) + (unsigned)sC[i]) * 2u; } } }
        for (int t = 0; t < nt; t += 2) {
            const bool last = (t == nt - 2);
            const char* a1 = cA + (size_t)(t + 1) * kstep;
            const char* a2 = last ? nA : cA + (size_t)(t + 2) * kstep; const char* b2 = last ? nB : cB + (size_t)(t + 2) * kstep;
            const char* a3 = a2 + kstep; const char* b3 = b2 + kstep;
            unsigned w0[2], w1[2];
#pragma unroll
            for (int i = 0; i < 2; ++i) { w0[i] = (GATHER && last) ? nvA0[i] : voffA0[i]; w1[i] = (GATHER && last) ? nvA1[i] : voffA1[i]; }
            PG_LDB(B0, 0, 0); PG_LDB(B1, 0, 1); PG_SCHED; PG_LDA(At, 0, 0); PG_STAGE(PG_SA(1, 1), a1, voffA1);
            PG_WAIT_V(8); PG_WAIT_L(0); PG_BAR; PG_MMA(0, 0, At, B0); PG_MMA(0, 1, At, B1); PG_BAR; PG_SCHED;
            PG_LDA(At, 0, 1); PG_STAGE(PG_SB(0, 0), b2, voffB); PG_STAGE(PG_SB(0, 1), b2 + hstepB, voffB); PG_STAGE(PG_SA(0, 0), a2, w0);
            PG_WAIT_V(8); PG_WAIT_L(0); PG_BAR; PG_MMA(1, 0, At, B0); PG_MMA(1, 1, At, B1); PG_BAR; PG_SCHED;
            PG_LDB(B0, 1, 0); PG_LDB(B1, 1, 1); PG_SCHED; PG_LDA(At, 1, 0); PG_STAGE(PG_SA(0, 1), a2, w1);
            PG_WAIT_V(8); PG_WAIT_L(0); PG_BAR; PG_MMA(0, 0, At, B0); PG_MMA(0, 1, At, B1); PG_BAR; PG_SCHED;
            PG_LDA(At, 1, 1); PG_STAGE(PG_SB(1, 0), b3, voffB); PG_STAGE(PG_SB(1, 1), b3 + hstepB, voffB); PG_STAGE(PG_SA(1, 0), a3, w0);
            PG_WAIT_V(8); PG_WAIT_L(0); PG_BAR; PG_MMA(1, 0, At, B0); PG_MMA(1, 1, At, B1); PG_BAR; PG_SCHED;
        }
        if constexpr (ALIGN_EPI) { if (wr == 0) PG_BAR; }
        E(acc, cur, wr, wc, fr, fq);
        if (!has_next) break;
#pragma unroll
        for (int a = 0; a < 2; ++a)
#pragma unroll
            for (int b = 0; b < 2; ++b)
#pragma unroll
                for (int m = 0; m < 4; ++m)
#pragma unroll
                    for (int n = 0; n < 2; ++n) acc[a][b][m][n] = (f32x4){0.f, 0.f, 0.f, 0.f};
        cur = nxt; cA = nA; cB = nB; ++ui;
        if constexpr (GATHER) {
#pragma unroll
            for (int i = 0; i < 2; ++i) { voffA0[i] = nvA0[i]; voffA1[i] = nvA1[i]; } }
        if constexpr (ALIGN_EPI) { if (wr == 1) PG_BAR; }
    }
    PG_WAIT_V(0);
    if constexpr (!ALIGN_EPI) { if (wr == 0) PG_BAR; }
    PG_BAR;
#undef PG_SA
#undef PG_SB
#undef PG_STAGE
#undef PG_LDA
#undef PG_LDB
#undef PG_MMA
#undef PG_WAIT_V
#undef PG_WAIT_L
#undef PG_BAR
#undef PG_SCHED
}
}

DEV u32x4 pack8(const float (&v)[8]) { u32x4 w; w.x = cvt_pk(v[0], v[1]); w.y = cvt_pk(v[2], v[3]); w.z = cvt_pk(v[4], v[5]); w.w = cvt_pk(v[6], v[7]); return w; }
#define PACC8(v, acc, ai, bj, m) { _Pragma("unroll") for (int _e = 0; _e < 4; ++_e) { v[_e] = acc[ai][bj][m][0][_e]; v[4 + _e] = acc[ai][bj][m][1][_e]; } }

struct OrderXcd { const char* A; const char* Bt; size_t astep, bstep; int NT, rounds, xcd, ci;
    DEV bool next(int i, pg::Unit& u) const { if (i >= rounds) return false; const int q = i * 32 + ci, per = 4 * NT, mg = q / per, rem = q % per;
        u.pn = rem >> 2; u.pm = xcd * 32 + mg * 4 + (rem & 3); u.a = A + (size_t)u.pm * astep; u.b = Bt + (size_t)u.pn * bstep; u.x0 = 0; u.x1 = 0; u.x2 = 0; return true; } };
struct OrderOne { pg::Unit u;
    DEV bool next(int i, pg::Unit& o) const { if (i) return false; o = u; return true; } };
struct OrderMoe1 { const char* X; const char* WGU; const unsigned* LISTB; const unsigned* cntp; LDS const int* tb; int ntile, bid;
    DEV bool next(int i, pg::Unit& u) const { const int q = bid + 256 * i; if (q >= ntile * 2) return false; const int rt = q >> 1, nt = q & 1, e = __builtin_amdgcn_readfirstlane(tb[128 + rt]);
        u.pm = rt; u.pn = nt; u.x0 = e; u.x1 = (rt - __builtin_amdgcn_readfirstlane(tb[e])) * 256; u.x2 = (int)cntp[e]; u.a = X; u.b = WGU + (size_t)(e * 512 + nt * 256) * 1024 * 2; return true; }
    DEV unsigned arow(const pg::Unit& u, int r) const { const int pos = u.x1 + r; return (pos < u.x2 ? (LISTB[(size_t)u.x0 * 65536 + pos] >> 1) : 0u) * 1024u; } };
struct OrderMoe2 { const char* HE; const char* WDT; LDS const int* tb; int ntile, bid;
    DEV bool next(int i, pg::Unit& u) const { const int q = bid + 256 * i; if (q >= ntile * 4) return false; const int rt = q >> 2, nt = q & 3, e = __builtin_amdgcn_readfirstlane(tb[128 + rt]);
        u.pm = rt; u.pn = nt; u.x0 = e; u.x1 = 0; u.x2 = 0; u.a = HE + (size_t)rt * 256 * 256 * 2; u.b = WDT + (size_t)(e * 1024 + nt * 256) * 256 * 2; return true; } };

struct EpiInProj { unsigned char* ws;
    DEV void operator()(const pg::Acc& acc, const pg::Unit& u, int wr, int wc, int fr, int fq) const {
        const float* rc = (const float*)(ws + OFF_ROPEC); const float* rsn = (const float*)(ws + OFF_ROPES);
        const int tok0 = u.pm * 256 + wr * 64 + fr, b = tok0 >> 11, s0 = tok0 & 2047;
#pragma unroll
        for (int bj = 0; bj < 2; ++bj) {
            const int cu = u.pn * 256 + bj * 128 + wc * 32;
            const int c = cu + 8 * fq;
            if (cu >= 2816) {
                if (c < NPROJ) {
#pragma unroll
                    for (int ai = 0; ai < 2; ++ai)
#pragma unroll
                        for (int m = 0; m < 4; ++m) { const int tok = tok0 + ai * 128 + m * 16; float v[8]; PACC8(v, acc, ai, bj, m);
                            float* g = (float*)(ws + OFF_GATE) + (size_t)tok * 24 + (c - 2816); f32x4 a, d;
#pragma unroll
                            for (int i = 0; i < 4; ++i) { a[i] = 1.f / (1.f + __expf(-v[i])); d[i] = 1.f / (1.f + __expf(-v[4 + i])); }
                            *(f32x4*)g = a; *(f32x4*)(g + 4) = d; } }
                continue;
            }
            size_t base; int head, nh; bool rp;
            if (cu < 2048) { const int reg = cu >> 9; base = OFF_R2 + (size_t)reg * (64 * MB); head = (cu & 511) >> 6; nh = 8; rp = (reg != 2); }
            else { const int reg = (cu - 2048) >> 7; base = OFF_KV6 + (size_t)reg * (16 * MB); head = ((cu - 2048) & 127) >> 6; nh = 2; rp = (reg == 2 || reg == 4); }
            bf16_t* dst0 = (bf16_t*)(ws + base) + ((size_t)(b * nh + head) * 2048 + s0) * 64 + (c & 63);
            if (rp && (cu & 63) == 0) {
                const int p0 = (c & 31) >> 1;
                f32x4 cs[8], sn[8];
#pragma unroll
                for (int q = 0; q < 8; ++q) { const int srow = s0 + (q >> 2) * 128 + (q & 3) * 16; cs[q] = *(const f32x4*)(rc + srow * 8 + (p0 & 4)); sn[q] = *(const f32x4*)(rsn + srow * 8 + (p0 & 4)); }
#pragma unroll
                for (int q = 0; q < 8; ++q) { const int ai = q >> 2, m = q & 3; float v[8]; PACC8(v, acc, ai, bj, m);
                    if (fq < 2) {
#pragma unroll
                        for (int pr = 0; pr < 4; ++pr) { const float x1 = v[2 * pr], x2 = v[2 * pr + 1]; v[2 * pr] = x1 * cs[q][pr] - x2 * sn[q][pr]; v[2 * pr + 1] = x2 * cs[q][pr] + x1 * sn[q][pr]; } }
                    *(u32x4*)(dst0 + (size_t)(ai * 128 + m * 16) * 64) = pack8(v); }
            } else {
#pragma unroll
                for (int q = 0; q < 8; ++q) { const int ai = q >> 2, m = q & 3; float v[8]; PACC8(v, acc, ai, bj, m);
                    *(u32x4*)(dst0 + (size_t)(ai * 128 + m * 16) * 64) = pack8(v); }
            }
        }
    }
};

DEV float gelu_tanh(float x) { const float u = 0.7978845608028654f * (x + 0.044715f * x * x * x); return 0.5f * x * (1.f + tanhf(u)); }
struct EpiCmp1 { unsigned char* ws; int kv;
    DEV void operator()(const pg::Acc& acc, const pg::Unit& u, int wr, int wc, int fr, int fq) const {
        const float* bias = (const float*)(ws + OFF_BIAS1) + kv * 256;
        bf16_t* HID = (bf16_t*)(ws + OFF_HID) + (size_t)kv * 8192 * 256;
#pragma unroll
        for (int ai = 0; ai < 2; ++ai)
#pragma unroll
            for (int m = 0; m < 4; ++m) { const int R = u.pm * 256 + ai * 128 + wr * 64 + m * 16 + fr;
#pragma unroll
                for (int bj = 0; bj < 2; ++bj) { const int n = bj * 128 + wc * 32 + 8 * fq; float v[8]; PACC8(v, acc, ai, bj, m);
#pragma unroll
                    for (int i = 0; i < 8; ++i) v[i] = gelu_tanh(v[i] + bias[n + i]);
                    *(u32x4*)(HID + (size_t)R * 256 + n) = pack8(v); } }
    }
};
struct EpiCmp2 { unsigned char* ws; int kv;
    DEV void operator()(const pg::Acc& acc, const pg::Unit& u, int wr, int wc, int fr, int fq) const {
        if (wc >= 2) return;
        const float* rc = (const float*)(ws + OFF_ROPEC); const float* rsn = (const float*)(ws + OFF_ROPES);
        bf16_t* OUT = (bf16_t*)(ws + (kv ? OFF_VC : OFF_KC));
#pragma unroll
        for (int ai = 0; ai < 2; ++ai)
#pragma unroll
            for (int m = 0; m < 4; ++m) { const int R = u.pm * 256 + ai * 128 + wr * 64 + m * 16 + fr, cidx = R & 127;
                const int n = wc * 32 + 8 * fq; float v[8]; PACC8(v, acc, ai, 0, m);
                if (kv == 0 && n < 16) { const int pos = (cidx < 127 ? cidx : 126) * 16 + 31, p0 = n >> 1;
                    const f32x4 cs = *(const f32x4*)(rc + pos * 8 + p0), sn = *(const f32x4*)(rsn + pos * 8 + p0);
#pragma unroll
                    for (int pr = 0; pr < 4; ++pr) { const float x1 = v[2 * pr], x2 = v[2 * pr + 1]; v[2 * pr] = x1 * cs[pr] - x2 * sn[pr]; v[2 * pr + 1] = x2 * cs[pr] + x1 * sn[pr]; } }
                if (cidx == 127) {
#pragma unroll
                    for (int i = 0; i < 8; ++i) v[i] = 0.f; }
                *(u32x4*)(OUT + (size_t)R * 64 + n) = pack8(v); }
    }
};

struct EpiOut { unsigned char* ws; const float* x;
    DEV void operator()(const pg::Acc& acc, const pg::Unit& u, int wr, int wc, int fr, int fq) const {
        bf16_t* XB = (bf16_t*)(ws + OFF_X1B); bf16_t* XL = (bf16_t*)(ws + OFF_X1L);
#pragma unroll
        for (int ai = 0; ai < 2; ++ai)
#pragma unroll
            for (int m = 0; m < 4; ++m) { const int tok = u.pm * 256 + ai * 128 + wr * 64 + m * 16 + fr;
#pragma unroll
                for (int bj = 0; bj < 2; ++bj) { const int n = u.pn * 256 + bj * 128 + wc * 32 + 8 * fq; float v[8], lo[8]; PACC8(v, acc, ai, bj, m);
                    const f32x4 xa = *(const f32x4*)(x + (size_t)tok * 1024 + n), xb = *(const f32x4*)(x + (size_t)tok * 1024 + n + 4);
#pragma unroll
                    for (int i = 0; i < 4; ++i) { v[i] += xa[i]; v[4 + i] += xb[i]; }
                    const u32x4 h = pack8(v);
                    lo[0] = v[0] - bf_lo(h.x); lo[1] = v[1] - bf_hi(h.x); lo[2] = v[2] - bf_lo(h.y); lo[3] = v[3] - bf_hi(h.y);
                    lo[4] = v[4] - bf_lo(h.z); lo[5] = v[5] - bf_hi(h.z); lo[6] = v[6] - bf_lo(h.w); lo[7] = v[7] - bf_hi(h.w);
                    *(u32x4*)(XB + (size_t)tok * 1024 + n) = h; *(u32x4*)(XL + (size_t)tok * 1024 + n) = pack8(lo); } }
    }
};

struct EpiMoe1 { unsigned char* ws;
    DEV void operator()(const pg::Acc& acc, const pg::Unit& u, int wr, int wc, int fr, int fq) const {
        const float* RS = (const float*)(ws + OFF_RSTD2); bf16_t* HE = (bf16_t*)(ws + OFF_HE); const unsigned* list = (const unsigned*)(ws + OFF_LIST) + (size_t)u.x0 * 65536;
#pragma unroll
        for (int ai = 0; ai < 2; ++ai)
#pragma unroll
            for (int m = 0; m < 4; ++m) { const int lr = ai * 128 + wr * 64 + m * 16 + fr, pos = u.x1 + lr; const int tok = pos < u.x2 ? (int)(list[pos] >> 1) : 0; const float r = RS[tok];
                const int j = u.pn * 128 + wc * 32 + 8 * fq; float g[8], up[8], v[8]; PACC8(g, acc, ai, 0, m); PACC8(up, acc, ai, 1, m);
#pragma unroll
                for (int i = 0; i < 8; ++i) { const float a = g[i] * r; v[i] = a / (1.f + __expf(-a)) * (up[i] * r); }
                *(u32x4*)(HE + (size_t)(u.pm * 256 + lr) * 256 + j) = pack8(v); }
    }
};
struct EpiMoe2 { unsigned char* ws;
    DEV void operator()(const pg::Acc& acc, const pg::Unit& u, int wr, int wc, int fr, int fq) const {
        bf16_t* Y = (bf16_t*)(ws + OFF_Y);
#pragma unroll
        for (int ai = 0; ai < 2; ++ai)
#pragma unroll
            for (int m = 0; m < 4; ++m) { const int lr = ai * 128 + wr * 64 + m * 16 + fr;
#pragma unroll
                for (int bj = 0; bj < 2; ++bj) { const int n = u.pn * 256 + bj * 128 + wc * 32 + 8 * fq; float v[8]; PACC8(v, acc, ai, bj, m);
                    *(u32x4*)(Y + (size_t)(u.pm * 256 + lr) * 1024 + n) = pack8(v); } }
    }
};

struct Flash { f32x16 o0, o1; float m, l; };
DEV void flash_init(Flash& s) {
#pragma unroll
    for (int i = 0; i < 16; ++i) { s.o0[i] = 0.f; s.o1[i] = 0.f; }
    s.m = -INFINITY; s.l = 0.f; }
DEV s16x4 tr_read(LDSP p) { return __builtin_bit_cast(s16x4, __builtin_amdgcn_ds_read_tr16_b64_v4i16((LDS s16x4*)p)); }

DEV void flash_stage(const u32x4 (&kch)[4], const u32x4 (&vch)[4], LDSP vl, int lane) {
    const int c = lane & 7, row = lane >> 3; const int wo = (c >> 2) * 2048 + row * 64 + (c & 3) * 16;
#pragma unroll
    for (int i = 0; i < 4; ++i) { const int r = row + 8 * i; *(LDS u32x4*)(vl + 4096 + r * 128 + ((c ^ ((r >> 1) & 7)) << 4)) = kch[i]; *(LDS u32x4*)(vl + wo + i * 512) = vch[i]; }
}
DEV void flash_tile(Flash& st, const bf16x8 (&qf)[4], LDSP vl, int rl, int rh, int lane) {
    const int hl = lane >> 5, l31 = lane & 31;
    asm volatile("s_waitcnt lgkmcnt(0)" ::: "memory");
    f32x16 s;
#pragma unroll
    for (int i = 0; i < 16; ++i) s[i] = 0.f;
#pragma unroll
    for (int ks = 0; ks < 4; ++ks) { const bf16x8 kf = *(const LDS bf16x8*)(vl + 4096 + l31 * 128 + (((2 * ks + hl) ^ ((l31 >> 1) & 7)) << 4)); s = MFMA32(kf, qf[ks], s); }
    float mx = -INFINITY;
    const bool lfull = (rl <= 0) && (rh >= 27), lnone = (rh < 0) || (rl > 27) || (rh < rl);
    bool lane_off = false;
    const bool interior = __all(lfull || lnone);
    if (__builtin_expect(interior, 1)) {
#pragma unroll
        for (int i = 0; i < 16; ++i) mx = fmaxf(mx, s[i]);
        lane_off = !lfull; mx = lane_off ? -INFINITY : mx;
    } else {
#pragma unroll
        for (int i = 0; i < 16; ++i) { const int ci = (i & 3) + 8 * (i >> 2); const bool ok = (ci >= rl) && (ci <= rh); mx = fmaxf(mx, ok ? s[i] : -INFINITY); }
    }
    mx = xhalf_max(mx);
    float rs = 0.f;
    const bool grow = mx > st.m + 8.0f;
    const bool moved = __any(grow);
    const float mnew = grow ? mx : st.m, ms = (mnew == -INFINITY) ? 0.f : mnew;
    const float alpha = fexp2(st.m - ms);
    const float msub = lane_off ? INFINITY : ms;
    float pe[16];
#pragma unroll
    for (int i = 0; i < 16; ++i) pe[i] = fexp2(s[i] - msub);
    if (__builtin_expect(!interior, 0)) {
#pragma unroll
        for (int i = 0; i < 16; ++i) { const int ci = (i & 3) + 8 * (i >> 2); const bool ok = (ci >= rl) && (ci <= rh); pe[i] = ok ? pe[i] : 0.f; }
    }
#pragma unroll
    for (int i = 0; i < 16; ++i) rs += pe[i];
    st.l = st.l * alpha + rs; st.m = mnew;
    if (__builtin_expect(moved, 0)) {
#pragma unroll
        for (int i = 0; i < 16; ++i) { st.o0[i] *= alpha; st.o1[i] *= alpha; }
    }
    unsigned pk[8];
#pragma unroll
    for (int j = 0; j < 8; ++j) pk[j] = cvt_pk(pe[2 * j], pe[2 * j + 1]);
    asm volatile("s_waitcnt lgkmcnt(0)" ::: "memory");
    const int rb = (hl * 4 + ((lane & 15) >> 2)) * 64 + ((lane >> 4) & 1) * 32 + (lane & 3) * 8;
#pragma unroll
    for (int s2 = 0; s2 < 2; ++s2) {
        u32x4 pw; pw.x = pk[4 * s2]; pw.y = pk[4 * s2 + 1]; pw.z = pk[4 * s2 + 2]; pw.w = pk[4 * s2 + 3];
        const bf16x8 pf = __builtin_bit_cast(bf16x8, pw);
        { const s16x4 v0 = tr_read(vl + (16 * s2) * 64 + rb), v1 = tr_read(vl + (16 * s2 + 8) * 64 + rb);
          const bf16x8 vf = __builtin_shufflevector(v0, v1, 0, 1, 2, 3, 4, 5, 6, 7); st.o0 = MFMA32(vf, pf, st.o0); }
        { const s16x4 v0 = tr_read(vl + 2048 + (16 * s2) * 64 + rb), v1 = tr_read(vl + 2048 + (16 * s2 + 8) * 64 + rb);
          const bf16x8 vf = __builtin_shufflevector(v0, v1, 0, 1, 2, 3, 4, 5, 6, 7); st.o1 = MFMA32(vf, pf, st.o1); }
    }
    asm volatile("s_waitcnt lgkmcnt(0)" ::: "memory");
}
DEV bool tile_need(int kt, int lo, int hi, unsigned selmask) { const int kb = kt * 32; const int hie = ((selmask >> (kt >> 1)) & 1u) ? hi : -1; return (hie >= kb) && (lo <= kb + 31) && (hie >= lo); }
#define FR_NEXT(k) do { ++(k); while ((k) < kt1 && !__any(tile_need((k), lo, hi, selmask))) ++(k); } while (0)
#define FR_LOAD(KR, VR, k) do { _Pragma("unroll") for (int i_ = 0; i_ < 4; ++i_) { KR[i_] = *(const u32x4*)(kp + (size_t)((k) * 32 + 8 * i_) * stride); VR[i_] = *(const u32x4*)(vp + (size_t)((k) * 32 + 8 * i_) * stride); } } while (0)
DEV void flash_range(Flash& st, const bf16x8 (&qf)[4], const bf16_t* kbase, const bf16_t* vbase, int stride, int kt0, int kt1, int lo, int hi, unsigned selmask, LDSP vl, int lane) {
    const int hl = lane >> 5;
    const bf16_t* kp = kbase + (size_t)(lane >> 3) * stride + (lane & 7) * 8;
    const bf16_t* vp = vbase + (size_t)(lane >> 3) * stride + (lane & 7) * 8;
    int ta = kt0 - 1; FR_NEXT(ta);
    if (ta >= kt1) return;
    u32x4 kA[4], vA[4], kB[4], vB[4];
    FR_LOAD(kA, vA, ta);
    int tb = ta; FR_NEXT(tb);
    if (tb < kt1) FR_LOAD(kB, vB, tb);
    int cur = 0;
    flash_stage(kA, vA, vl, lane);
    int tc = tb; if (tb < kt1) { FR_NEXT(tc); if (tc < kt1) FR_LOAD(kA, vA, tc); }
    for (;;) {
        { const int kb = ta * 32; const int hie = ((selmask >> (ta >> 1)) & 1u) ? hi : -1; flash_tile(st, qf, vl + cur, lo - kb - 4 * hl, hie - kb - 4 * hl, lane); }
        if (tb >= kt1) break;
        cur ^= 8192; flash_stage(kB, vB, vl + cur, lane);
        ta = tb; tb = tc; if (tc < kt1) { FR_NEXT(tc); if (tc < kt1) FR_LOAD(kB, vB, tc); }
        { const int kb = ta * 32; const int hie = ((selmask >> (ta >> 1)) & 1u) ? hi : -1; flash_tile(st, qf, vl + cur, lo - kb - 4 * hl, hie - kb - 4 * hl, lane); }
        if (tb >= kt1) break;
        cur ^= 8192; flash_stage(kA, vA, vl + cur, lane);
        ta = tb; tb = tc; if (tc < kt1) { FR_NEXT(tc); if (tc < kt1) FR_LOAD(kA, vA, tc); }
    }
}
#undef FR_NEXT
#undef FR_LOAD
DEV float flash_final(Flash& st) { const float lt = xhalf_sum(st.l); const float inv = lt > 0.f ? 1.f / lt : 0.f;
#pragma unroll
    for (int i = 0; i < 16; ++i) { st.o0[i] *= inv; st.o1[i] *= inv; }
    return lt; }
DEV void store_o(bf16_t* dst  , const f32x16& o0, const f32x16& o1, int hl) {
#pragma unroll
    for (int g = 0; g < 4; ++g) { u32x2 w; w.x = cvt_pk(o0[4 * g], o0[4 * g + 1]); w.y = cvt_pk(o0[4 * g + 2], o0[4 * g + 3]); *(u32x2*)(dst + 8 * g + 4 * hl) = w;
        u32x2 z; z.x = cvt_pk(o1[4 * g], o1[4 * g + 1]); z.y = cvt_pk(o1[4 * g + 2], o1[4 * g + 3]); *(u32x2*)(dst + 32 + 8 * g + 4 * hl) = z; }
}
DEV unsigned wave_pull(unsigned* ctr, int lane) { unsigned v = 0; if (lane == 0) v = __hip_atomic_fetch_add(ctr, 1u, __ATOMIC_RELAXED, __HIP_MEMORY_SCOPE_AGENT); return (unsigned)__builtin_amdgcn_readfirstlane((int)v); }

DEV void dilated_task(const Params& p, int id, LDSP vl, int lane) {
    unsigned char* ws = p.ws; const int l31 = lane & 31, hl = lane >> 5;
    const int j = id & 63, pat = (id >> 6) % 3, bh = id / 192;
    int dil, r, qb;
    if (pat == 0) { dil = 1; r = 0; qb = j; } else if (pat == 1) { dil = 4; r = j >> 4; qb = j & 15; } else { dil = 16; r = j >> 2; qb = j & 3; }
    const bf16_t* Q = (const bf16_t*)(ws + OFF_QA) + (size_t)bh * 2048 * 64 + r * 64;
    const bf16_t* K = (const bf16_t*)(ws + OFF_KA) + (size_t)bh * 2048 * 64 + r * 64;
    const bf16_t* V = (const bf16_t*)(ws + OFF_VA) + (size_t)bh * 2048 * 64 + r * 64;
    const int stride = dil * 64, mq = qb * 32 + l31;
    bf16x8 qf[4];
#pragma unroll
    for (int ks = 0; ks < 4; ++ks) qf[ks] = *(const bf16x8*)(Q + (size_t)mq * stride + ks * 16 + hl * 8);
    Flash st; flash_init(st);
    flash_range(st, qf, K, V, stride, qb >= 4 ? qb - 4 : 0, qb + 1, mq >= 128 ? mq - 128 : 0, mq, 0xffffffffu, vl, lane);
    const float lt = flash_final(st);
    const int b = bh >> 3, h = bh & 7, tok = b * 2048 + mq * dil + r;
    store_o((bf16_t*)(ws + OFF_OP) + ((size_t)pat * T_TOK + tok) * 512 + h * 64, st.o0, st.o1, hl);
    if (hl == 0) __hip_atomic_store((float*)(ws + OFF_LSE) + ((size_t)pat * T_TOK + tok) * 8 + h, st.m + __builtin_log2f(lt), __ATOMIC_RELAXED, __HIP_MEMORY_SCOPE_AGENT);
}

DEV void dilated_pair(const Params& p, int id, LDSP vl, int lane) {
    unsigned char* ws = p.ws; const int l31 = lane & 31, hl = lane >> 5;
    const int j = id & 31, pat = (id >> 5) % 3, bh = id / 96;
    int dil, r, qb;
    if (pat == 0) { dil = 1; r = 0; qb = 2 * j; } else if (pat == 1) { dil = 4; r = j >> 3; qb = 2 * (j & 7); } else { dil = 16; r = j >> 1; qb = 2 * (j & 1); }
    const bf16_t* Q = (const bf16_t*)(ws + OFF_QA) + (size_t)bh * 2048 * 64 + r * 64;
    const bf16_t* K = (const bf16_t*)(ws + OFF_KA) + (size_t)bh * 2048 * 64 + r * 64;
    const bf16_t* V = (const bf16_t*)(ws + OFF_VA) + (size_t)bh * 2048 * 64 + r * 64;
    const int stride = dil * 64, mqA = qb * 32 + l31, mqB = mqA + 32;
    bf16x8 qfA[4], qfB[4];
#pragma unroll
    for (int ks = 0; ks < 4; ++ks) { qfA[ks] = *(const bf16x8*)(Q + (size_t)mqA * stride + ks * 16 + hl * 8); qfB[ks] = *(const bf16x8*)(Q + (size_t)mqB * stride + ks * 16 + hl * 8); }
    Flash sA, sB; flash_init(sA); flash_init(sB);
    const int loA = mqA >= 128 ? mqA - 128 : 0, loB = mqB >= 128 ? mqB - 128 : 0;
    const int kt1 = qb + 2;
    int ta = qb >= 4 ? qb - 4 : 0;
    const bf16_t* kp = K + (size_t)(lane >> 3) * stride + (lane & 7) * 8;
    const bf16_t* vp = V + (size_t)(lane >> 3) * stride + (lane & 7) * 8;
#define DP_LOAD(KR, VR, k) do { _Pragma("unroll") for (int i_ = 0; i_ < 4; ++i_) { KR[i_] = *(const u32x4*)(kp + (size_t)((k) * 32 + 8 * i_) * stride); VR[i_] = *(const u32x4*)(vp + (size_t)((k) * 32 + 8 * i_) * stride); } } while (0)
#define DP_TILE(kt, buf) do { const int kb_ = (kt) * 32; \
        if ((kt) <= qb) flash_tile(sA, qfA, (buf), loA - kb_ - 4 * hl, mqA - kb_ - 4 * hl, lane); \
        if ((kt) >= qb - 3) flash_tile(sB, qfB, (buf), loB - kb_ - 4 * hl, mqB - kb_ - 4 * hl, lane); } while (0)
    u32x4 kA[4], vA[4], kB[4], vB[4];
    DP_LOAD(kA, vA, ta);
    DP_LOAD(kB, vB, ta + 1);
    int cur = 0;
    flash_stage(kA, vA, vl, lane);
    if (ta + 2 < kt1) DP_LOAD(kA, vA, ta + 2);
    for (;;) {
        DP_TILE(ta, vl + cur);
        if (ta + 1 >= kt1) break;
        cur ^= 8192; flash_stage(kB, vB, vl + cur, lane);
        ++ta; if (ta + 2 < kt1) DP_LOAD(kB, vB, ta + 2);
        DP_TILE(ta, vl + cur);
        if (ta + 1 >= kt1) break;
        cur ^= 8192; flash_stage(kA, vA, vl + cur, lane);
        ++ta; if (ta + 2 < kt1) DP_LOAD(kA, vA, ta + 2);
    }
#undef DP_LOAD
#undef DP_TILE
    const int b = bh >> 3, h = bh & 7;
    { const float lt = flash_final(sA); const int tok = b * 2048 + mqA * dil + r;
      store_o((bf16_t*)(ws + OFF_OP) + ((size_t)pat * T_TOK + tok) * 512 + h * 64, sA.o0, sA.o1, hl);
      if (hl == 0) __hip_atomic_store((float*)(ws + OFF_LSE) + ((size_t)pat * T_TOK + tok) * 8 + h, sA.m + __builtin_log2f(lt), __ATOMIC_RELAXED, __HIP_MEMORY_SCOPE_AGENT); }
    { const float lt = flash_final(sB); const int tok = b * 2048 + mqB * dil + r;
      store_o((bf16_t*)(ws + OFF_OP) + ((size_t)pat * T_TOK + tok) * 512 + h * 64, sB.o0, sB.o1, hl);
      if (hl == 0) __hip_atomic_store((float*)(ws + OFF_LSE) + ((size_t)pat * T_TOK + tok) * 8 + h, sB.m + __builtin_log2f(lt), __ATOMIC_RELAXED, __HIP_MEMORY_SCOPE_AGENT); }
}

DEV void merge_tokens(const Params& p, int lane, int wid) {
    unsigned char* ws = p.ws; const bf16_t* OP = (const bf16_t*)(ws + OFF_OP); const float* LSE = (const float*)(ws + OFF_LSE); bf16_t* MIX = (bf16_t*)(ws + OFF_R1);
    const int h = lane >> 3, d0 = (lane & 7) * 8;
    for (int tok = blockIdx.x * 8 + wid; tok < T_TOK; tok += 2048) {
        float l0 = LSE[(size_t)tok * 8 + h], l1 = LSE[((size_t)T_TOK + tok) * 8 + h], l2 = LSE[((size_t)2 * T_TOK + tok) * 8 + h];
        const float mx = fmaxf(l0, fmaxf(l1, l2)); l0 = fexp2(l0 - mx); l1 = fexp2(l1 - mx); l2 = fexp2(l2 - mx); const float inv = 1.f / (l0 + l1 + l2); l0 *= inv; l1 *= inv; l2 *= inv;
        const u32x4 a = *(const u32x4*)(OP + (size_t)tok * 512 + h * 64 + d0), b = *(const u32x4*)(OP + ((size_t)T_TOK + tok) * 512 + h * 64 + d0), c = *(const u32x4*)(OP + ((size_t)2 * T_TOK + tok) * 512 + h * 64 + d0);
        u32x4 w;
#pragma unroll
        for (int i = 0; i < 4; ++i) { const float lo = l0 * bf_lo(a[i]) + l1 * bf_lo(b[i]) + l2 * bf_lo(c[i]), hi = l0 * bf_hi(a[i]) + l1 * bf_hi(b[i]) + l2 * bf_hi(c[i]); w[i] = cvt_pk(lo, hi); }
        *(u32x4*)(MIX + (size_t)tok * 1024 + h * 64 + d0) = w;
    }
}

DEV void nsa_sel_task(const Params& p, int qb, int bg, int lane) {
    unsigned char* ws = p.ws; const int l31 = lane & 31, hl = lane >> 5;
    const int b = bg >> 1, g = bg & 1, t0 = qb * 32, t = t0 + l31, tok = b * 2048 + t;
    const bf16_t* KC = (const bf16_t*)(ws + OFF_KC) + (size_t)bg * 128 * 64; const bf16_t* VC = (const bf16_t*)(ws + OFF_VC) + (size_t)bg * 128 * 64;
    const bf16_t* KS = (const bf16_t*)(ws + OFF_KV6 + 2 * 16 * MB) + (size_t)bg * 2048 * 64; const bf16_t* VS = (const bf16_t*)(ws + OFF_KV6 + 3 * 16 * MB) + (size_t)bg * 2048 * 64;
    const bf16_t* KW = (const bf16_t*)(ws + OFF_KV6 + 4 * 16 * MB) + (size_t)bg * 2048 * 64; const bf16_t* VW = (const bf16_t*)(ws + OFF_KV6 + 5 * 16 * MB) + (size_t)bg * 2048 * 64;
    const bf16_t* QBp = (const bf16_t*)(ws + OFF_QB) + ((size_t)(b * 8 + g * 4) * 2048 + t) * 64 + hl * 8;
    const int cmax = (t >= 31) ? (((t - 31) >> 4) < 126 ? ((t - 31) >> 4) : 126) : -1;
    f32x16 ps[4];
#pragma unroll
    for (int ct = 0; ct < 4; ++ct)
#pragma unroll
        for (int i = 0; i < 16; ++i) ps[ct][i] = 0.f;
#pragma unroll 1
    for (int r = 0; r < 4; ++r) {
        bf16x8 qf[4];
#pragma unroll
        for (int ks = 0; ks < 4; ++ks) qf[ks] = *(const bf16x8*)(QBp + (size_t)r * 2048 * 64 + ks * 16);
        float mx = -INFINITY, sum = 0.f;
#pragma unroll 1
        for (int ct = 0; ct < 4; ++ct) {
            f32x16 sc;
#pragma unroll
            for (int i = 0; i < 16; ++i) sc[i] = 0.f;
#pragma unroll
            for (int ks = 0; ks < 4; ++ks) { const bf16x8 kf = *(const bf16x8*)(KC + (size_t)(ct * 32 + l31) * 64 + ks * 16 + hl * 8); sc = MFMA32(kf, qf[ks], sc); }
            float tm = -INFINITY;
#pragma unroll
            for (int i = 0; i < 16; ++i) { const int c = ct * 32 + (i & 3) + 8 * (i >> 2) + 4 * hl; sc[i] = (c <= cmax) ? sc[i] : -INFINITY; tm = fmaxf(tm, sc[i]); }
            const float mn = fmaxf(mx, tm), ms = (mn == -INFINITY) ? 0.f : mn;
            float rs = 0.f;
#pragma unroll
            for (int i = 0; i < 16; ++i) rs += fexp2(sc[i] - ms);
            sum = sum * fexp2(mx - ms) + rs; mx = mn;
        }
        { const float mo = __shfl_xor(mx, 32), so = __shfl_xor(sum, 32); const float mn = fmaxf(mx, mo), ms = (mn == -INFINITY) ? 0.f : mn;
          sum = sum * fexp2(mx - ms) + so * fexp2(mo - ms); mx = ms; }
        const float inv = sum > 0.f ? 1.f / sum : 0.f;
#pragma unroll
        for (int ct = 0; ct < 4; ++ct) {
            f32x16 sc;
#pragma unroll
            for (int i = 0; i < 16; ++i) sc[i] = 0.f;
#pragma unroll
            for (int ks = 0; ks < 4; ++ks) { const bf16x8 kf = *(const bf16x8*)(KC + (size_t)(ct * 32 + l31) * 64 + ks * 16 + hl * 8); sc = MFMA32(kf, qf[ks], sc); }
#pragma unroll
            for (int i = 0; i < 16; ++i) { const int c = ct * 32 + (i & 3) + 8 * (i >> 2) + 4 * hl; const float e = (c <= cmax) ? fexp2(sc[i] - mx) * inv : 0.f; ps[ct][i] += e; }
        }
    }
    float ie[16], io[16];
    {
        float A[16], Tp[16];
#pragma unroll
        for (int ct = 0; ct < 4; ++ct)
#pragma unroll
            for (int gq = 0; gq < 4; ++gq) { const int jj = ct * 4 + gq; const float p3 = 0.5f * ps[ct][4 * gq + 3]; A[jj] = ps[ct][4 * gq] + ps[ct][4 * gq + 1] + ps[ct][4 * gq + 2] + p3; Tp[jj] = __shfl_xor(p3, 32); }
#pragma unroll
        for (int jj = 0; jj < 16; ++jj) { const float prev = (jj > 0) ? Tp[jj > 0 ? jj - 1 : 0] : 0.f; const float own = A[jj] + (hl ? Tp[jj] : prev); const float oth = __shfl_xor(own, 32);
            ie[jj] = hl ? oth : own; io[jj] = hl ? own : oth; }
    }
    const int blk = t0 >> 6;
    unsigned sel = 1u | (1u << blk) | (blk > 0 ? (1u << (blk - 1)) : 0u);
    {
        const int nforced = blk >= 2 ? 3 : blk + 1, nsel = 8 - nforced, ncand = blk - 2;
        if (ncand > 0) {
            if (ncand <= nsel) sel |= ((1u << (blk - 1)) - 2u);
            else {
#pragma unroll
                for (int jj = 0; jj < 16; ++jj) { const int je = 2 * jj, jo = 2 * jj + 1; ie[jj] = (je >= 1 && je <= blk - 2) ? ie[jj] : -1.f; io[jj] = (jo >= 1 && jo <= blk - 2) ? io[jj] : -1.f; }
                unsigned bits = 0u;
#pragma unroll
                for (int jj = 0; jj < 16; ++jj) {
                    const float cj = hl ? io[jj] : ie[jj]; int cnt = 0;
#pragma unroll
                    for (int j2 = 0; j2 < 16; ++j2) {
                        const bool lte = (j2 < jj) || (j2 == jj && hl);
                        const bool lto = (j2 < jj);
                        cnt += ((ie[j2] > cj) || (ie[j2] == cj && lte)) ? 1 : 0;
                        cnt += ((io[j2] > cj) || (io[j2] == cj && lto)) ? 1 : 0;
                    }
                    if (cj >= 0.f && cnt < nsel) bits |= (1u << (2 * jj)) << hl;
                }
                bits |= (unsigned)__shfl_xor((int)bits, 32);
                sel |= bits;
            }
        }
    }
    if (hl == 0) ((unsigned*)(ws + OFF_SEL))[(size_t)bg * 2048 + t] = sel;
}

DEV void nsa_head_task(const Params& p, int qb, int bg, int r, LDSP vl, int lane) {
    unsigned char* ws = p.ws; const int l31 = lane & 31, hl = lane >> 5;
    const int b = bg >> 1, g = bg & 1, t0 = qb * 32, t = t0 + l31, tok = b * 2048 + t;
    const bf16_t* KC = (const bf16_t*)(ws + OFF_KC) + (size_t)bg * 128 * 64; const bf16_t* VC = (const bf16_t*)(ws + OFF_VC) + (size_t)bg * 128 * 64;
    const bf16_t* KS = (const bf16_t*)(ws + OFF_KV6 + 2 * 16 * MB) + (size_t)bg * 2048 * 64; const bf16_t* VS = (const bf16_t*)(ws + OFF_KV6 + 3 * 16 * MB) + (size_t)bg * 2048 * 64;
    const bf16_t* KW = (const bf16_t*)(ws + OFF_KV6 + 4 * 16 * MB) + (size_t)bg * 2048 * 64; const bf16_t* VW = (const bf16_t*)(ws + OFF_KV6 + 5 * 16 * MB) + (size_t)bg * 2048 * 64;
    const bf16_t* QBp = (const bf16_t*)(ws + OFF_QB) + ((size_t)(b * 8 + g * 4 + r) * 2048 + t) * 64 + hl * 8;
    const int cmax = (t >= 31) ? (((t - 31) >> 4) < 126 ? ((t - 31) >> 4) : 126) : -1;
    const unsigned sel = ((const unsigned*)(ws + OFF_SEL))[(size_t)bg * 2048 + t];
    const float* GT = (const float*)(ws + OFF_GATE) + (size_t)tok * 24 + (g * 4 + r) * 3;
    bf16_t* MIX = (bf16_t*)(ws + OFF_R1) + (size_t)tok * 1024 + 512 + (g * 4 + r) * 64;
    const int wlo = t >= 511 ? t - 511 : 0, wk0 = (t0 >> 5) >= 16 ? (t0 >> 5) - 16 : 0, kend = (t0 >> 5) + 1;
    bf16x8 qf[4];
#pragma unroll
    for (int ks = 0; ks < 4; ++ks) qf[ks] = *(const bf16x8*)(QBp + ks * 16);
    const float g0 = GT[0], g1 = GT[1], g2 = GT[2];
    f32x16 t0a, t1a;
    { Flash st; flash_init(st); flash_range(st, qf, KC, VC, 64, 0, 4, 0, cmax, 0xffffffffu, vl, lane); flash_final(st);
#pragma unroll
      for (int i = 0; i < 16; ++i) { t0a[i] = g0 * st.o0[i]; t1a[i] = g0 * st.o1[i]; } }
    { Flash st; flash_init(st); flash_range(st, qf, KS, VS, 64, 0, kend, 0, t, sel, vl, lane); flash_final(st);
#pragma unroll
      for (int i = 0; i < 16; ++i) { t0a[i] += g1 * st.o0[i]; t1a[i] += g1 * st.o1[i]; } }
    { Flash st; flash_init(st); flash_range(st, qf, KW, VW, 64, wk0, kend, wlo, t, 0xffffffffu, vl, lane); flash_final(st);
#pragma unroll
      for (int i = 0; i < 16; ++i) { t0a[i] += g2 * st.o0[i]; t1a[i] += g2 * st.o1[i]; } }
    store_o(MIX, t0a, t1a, hl);
}

DEV void wg_sync() { asm volatile("s_waitcnt lgkmcnt(0)" ::: "memory"); __builtin_amdgcn_s_barrier(); asm volatile("" ::: "memory"); }
DEV void coop_branch(Flash& st, const bf16x8 (&qf)[4], const bf16_t* kbase, const bf16_t* vbase, int j0, int j1, unsigned blockmask, int lo, int hi, unsigned selmask, LDSP sb, int tid, int lane) {
    const int hl = lane >> 5;
    const int sh = tid >> 8, lt = tid & 255, row = lt >> 3, c = lt & 7;
    const bf16_t* src = (sh ? vbase : kbase) + (size_t)row * 64 + c * 8;
    const int dsto = sh ? ((c >> 2) * 2048 + row * 64 + (c & 3) * 16) : (4096 + row * 128 + ((c ^ ((row >> 1) & 7)) << 4));
#define CB_NEXT(k) do { ++(k); while ((k) < j1 && !((blockmask >> (k)) & 1u)) ++(k); } while (0)
    int ja = j0 - 1; CB_NEXT(ja);
    if (ja >= j1) return;
    u32x4 r0 = *(const u32x4*)(src + (size_t)ja * 64 * 64), r1 = *(const u32x4*)(src + (size_t)(ja * 64 + 32) * 64);
    int jb = ja; CB_NEXT(jb);
    *(LDS u32x4*)(sb + dsto) = r0; *(LDS u32x4*)(sb + 8192 + dsto) = r1;
    if (jb < j1) { r0 = *(const u32x4*)(src + (size_t)jb * 64 * 64); r1 = *(const u32x4*)(src + (size_t)(jb * 64 + 32) * 64); }
    wg_sync();
    int cur = 0;
    for (;;) {
        const int hie = ((selmask >> ja) & 1u) ? hi : -1;
#pragma unroll
        for (int h2 = 0; h2 < 2; ++h2) { const int kb = ja * 64 + h2 * 32;
            if (__any((hie >= kb) && (lo <= kb + 31) && (hie >= lo))) flash_tile(st, qf, sb + cur + h2 * 8192, lo - kb - 4 * hl, hie - kb - 4 * hl, lane); }
        if (jb >= j1) break;
        *(LDS u32x4*)(sb + (cur ^ 16384) + dsto) = r0; *(LDS u32x4*)(sb + (cur ^ 16384) + 8192 + dsto) = r1;
        int jc = jb; CB_NEXT(jc);
        if (jc < j1) { r0 = *(const u32x4*)(src + (size_t)jc * 64 * 64); r1 = *(const u32x4*)(src + (size_t)(jc * 64 + 32) * 64); }
        wg_sync();
        cur ^= 16384; ja = jb; jb = jc;
    }
    wg_sync();
#undef CB_NEXT
}
DEV void nsa_wg_task(const Params& p, int qq, int bg, LDSP lds, int tid, int lane, int wid) {
    unsigned char* ws = p.ws; const int l31 = lane & 31, hl = lane >> 5, r = wid & 3, half = wid >> 2;
    const int b = bg >> 1, g = bg & 1, t0 = qq * 64 + 32 * half, t = t0 + l31, tok = b * 2048 + t;
    const bf16_t* KC = (const bf16_t*)(ws + OFF_KC) + (size_t)bg * 128 * 64; const bf16_t* VC = (const bf16_t*)(ws + OFF_VC) + (size_t)bg * 128 * 64;
    const bf16_t* KS = (const bf16_t*)(ws + OFF_KV6 + 2 * 16 * MB) + (size_t)bg * 2048 * 64; const bf16_t* VS = (const bf16_t*)(ws + OFF_KV6 + 3 * 16 * MB) + (size_t)bg * 2048 * 64;
    const bf16_t* KW = (const bf16_t*)(ws + OFF_KV6 + 4 * 16 * MB) + (size_t)bg * 2048 * 64; const bf16_t* VW = (const bf16_t*)(ws + OFF_KV6 + 5 * 16 * MB) + (size_t)bg * 2048 * 64;
    const bf16_t* QBp = (const bf16_t*)(ws + OFF_QB) + ((size_t)(b * 8 + g * 4 + r) * 2048 + t) * 64 + hl * 8;
    const int cmax = (t >= 31) ? (((t - 31) >> 4) < 126 ? ((t - 31) >> 4) : 126) : -1;
    const unsigned sel = ((const unsigned*)(ws + OFF_SEL))[(size_t)bg * 2048 + t];
    unsigned um = 0u;
#pragma unroll
    for (int j = 0; j < 32; ++j) um |= __any((sel >> j) & 1u) ? (1u << j) : 0u;
    LDS unsigned* xw = (LDS unsigned*)(lds + 32768);
    if (lane == 0) xw[wid] = um;
    wg_sync();
    um = xw[0] | xw[4];
    const float* GT = (const float*)(ws + OFF_GATE) + (size_t)tok * 24 + (g * 4 + r) * 3;
    bf16_t* MIX = (bf16_t*)(ws + OFF_R1) + (size_t)tok * 1024 + 512 + (g * 4 + r) * 64;
    const int wlo = t >= 511 ? t - 511 : 0, jend = qq + 1, wj0 = qq >= 8 ? qq - 8 : 0;
    bf16x8 qf[4];
#pragma unroll
    for (int ks = 0; ks < 4; ++ks) qf[ks] = *(const bf16x8*)(QBp + ks * 16);
    const float g0 = GT[0], g1 = GT[1], g2 = GT[2];
    f32x16 t0a, t1a;
    { Flash st; flash_init(st); coop_branch(st, qf, KC, VC, 0, 2, 0xffffffffu, 0, cmax, 0xffffffffu, lds, tid, lane); flash_final(st);
#pragma unroll
      for (int i = 0; i < 16; ++i) { t0a[i] = g0 * st.o0[i]; t1a[i] = g0 * st.o1[i]; } }
    { Flash st; flash_init(st); coop_branch(st, qf, KS, VS, 0, jend, um, 0, t, sel, lds, tid, lane); flash_final(st);
#pragma unroll
      for (int i = 0; i < 16; ++i) { t0a[i] += g1 * st.o0[i]; t1a[i] += g1 * st.o1[i]; } }
    { Flash st; flash_init(st); coop_branch(st, qf, KW, VW, wj0, jend, 0xffffffffu, wlo, t, 0xffffffffu, lds, tid, lane); flash_final(st);
#pragma unroll
      for (int i = 0; i < 16; ++i) { t0a[i] += g2 * st.o0[i]; t1a[i] += g2 * st.o1[i]; } }
    store_o(MIX, t0a, t1a, hl);
}

DEV void router_wave(const Params& p, int tok0, int lane, int wid, LDSP lds) {
    unsigned char* ws = p.ws; const int l31 = lane & 31, hl = lane >> 5, tok = tok0 + l31;
    const bf16_t* xh = (const bf16_t*)(ws + OFF_X1B) + (size_t)tok * 1024 + hl * 8; const bf16_t* xl = (const bf16_t*)(ws + OFF_X1L) + (size_t)tok * 1024 + hl * 8;
    const bf16_t* WR = (const bf16_t*)(ws + OFF_WRT);
    const int r8 = lane >> 3, slot = lane & 7;
    unsigned wo[3];
#pragma unroll
    for (int i = 0; i < 3; ++i) { const int R = 24 * wid + 8 * i + r8; wo[i] = (unsigned)(R < 96 ? R : R + 32) * 1024u + (unsigned)((slot ^ ((R >> 1) & 7)) << 3); }
    const int dw = wid * 3072;
    const int fbo = l31 * 128, sw = (l31 >> 1) & 7;
    f32x16 acc[3];
#pragma unroll
    for (int a = 0; a < 3; ++a)
#pragma unroll
        for (int i = 0; i < 16; ++i) acc[a][i] = 0.f;
    float ss = 0.f;
    asm volatile("s_waitcnt lgkmcnt(0)" ::: "memory");
    __builtin_amdgcn_s_barrier();
    asm volatile("" ::: "memory");
#pragma unroll
    for (int i = 0; i < 3; ++i) GLDS16(WR + wo[i], dw + i * 1024);
    u32x4 aN[8];
#pragma unroll
    for (int ks = 0; ks < 4; ++ks) { aN[2 * ks] = *(const u32x4*)(xh + ks * 16); aN[2 * ks + 1] = *(const u32x4*)(xl + ks * 16); }
#pragma unroll 1
    for (int kt = 0; kt < 16; ++kt) {
        asm volatile("s_waitcnt vmcnt(0)" ::: "memory");
        __builtin_amdgcn_s_barrier();
        asm volatile("" ::: "memory");
        u32x4 aC[8];
#pragma unroll
        for (int i = 0; i < 8; ++i) aC[i] = aN[i];
        const int cur = (kt & 1) * 24576;
        if (kt + 1 < 16) { const int ko = (kt + 1) * 64;
#pragma unroll
            for (int ks = 0; ks < 4; ++ks) { aN[2 * ks] = *(const u32x4*)(xh + ko + ks * 16); aN[2 * ks + 1] = *(const u32x4*)(xl + ko + ks * 16); }
#pragma unroll
            for (int i = 0; i < 3; ++i) GLDS16(WR + (wo[i] + (unsigned)ko), (24576 - cur) + dw + i * 1024); }
#pragma unroll
        for (int ks = 0; ks < 4; ++ks) {
            const u32x4 ahu = aC[2 * ks], alu = aC[2 * ks + 1];
#pragma unroll
            for (int i = 0; i < 4; ++i) { const float a = bf_lo(ahu[i]) + bf_lo(alu[i]), c = bf_hi(ahu[i]) + bf_hi(alu[i]); ss += a * a + c * c; }
            const bf16x8 ah = __builtin_bit_cast(bf16x8, ahu), al = __builtin_bit_cast(bf16x8, alu);
            const int ch = ((2 * ks + hl) ^ sw) << 4;
#pragma unroll
            for (int gr = 0; gr < 3; ++gr) { const bf16x8 bh = *(const LDS bf16x8*)(lds + cur + gr * 4096 + fbo + ch), bl = *(const LDS bf16x8*)(lds + cur + 12288 + gr * 4096 + fbo + ch);
                acc[gr] = MFMA32(bh, ah, acc[gr]); acc[gr] = MFMA32(bh, al, acc[gr]); acc[gr] = MFMA32(bl, ah, acc[gr]); }
        }
    }
    ss += __shfl_xor(ss, 32);
    const float rstd = 1.0f / sqrtf(ss * (1.0f / 1024.0f) + EPSN);
    int gs = 0; float pg;
    { float lg[8], mx = -INFINITY;
#pragma unroll
      for (int i = 0; i < 8; ++i) { lg[i] = acc[0][i] * rstd + p.b_rg[i]; if (lg[i] > mx) { mx = lg[i]; gs = i; } }
      float z = 0.f;
#pragma unroll
      for (int i = 0; i < 8; ++i) z += __expf(lg[i] - mx);
      pg = 1.f / z; }
    { const int go = __shfl_xor(gs, 32); const float po = __shfl_xor(pg, 32); if (hl) { gs = go; pg = po; } }
    const int ci = gs >> 1;
    float el[8];
#pragma unroll
    for (int k = 0; k < 8; ++k) {
        const float h1 = ci == 0 ? acc[0][k] : ci == 1 ? acc[0][8 + k] : ci == 2 ? acc[1][k] : acc[1][8 + k];
        const float h0 = ci == 0 ? acc[0][8 + k] : ci == 1 ? acc[1][k] : ci == 2 ? acc[1][8 + k] : acc[2][k];
        el[k] = (hl ? h1 : h0) * rstd + p.b_re[gs * 8 + k];
    }
    if (hl == 1 - (gs & 1)) {
        int i1 = 0; float m1 = -INFINITY;
#pragma unroll
        for (int k = 0; k < 8; ++k) if (el[k] > m1) { m1 = el[k]; i1 = k; }
        int i2 = 0; float m2 = -INFINITY;
#pragma unroll
        for (int k = 0; k < 8; ++k) if (k != i1 && el[k] > m2) { m2 = el[k]; i2 = k; }
        const float e2 = __expf(m2 - m1), w1 = pg / (1.f + e2), w2 = pg * e2 / (1.f + e2);
        const int ex1 = gs * 8 + i1, ex2 = gs * 8 + i2;
        unsigned* cnt = (unsigned*)(ws + OFF_CNT); unsigned* LIST = (unsigned*)(ws + OFF_LIST);
        const unsigned p1 = __hip_atomic_fetch_add(cnt + ex1, 1u, __ATOMIC_RELAXED, __HIP_MEMORY_SCOPE_AGENT);
        const unsigned p2 = __hip_atomic_fetch_add(cnt + ex2, 1u, __ATOMIC_RELAXED, __HIP_MEMORY_SCOPE_AGENT);
        __hip_atomic_store(LIST + (size_t)ex1 * 65536 + p1, (unsigned)tok * 2u, __ATOMIC_RELAXED, __HIP_MEMORY_SCOPE_AGENT);
        __hip_atomic_store(LIST + (size_t)ex2 * 65536 + p2, (unsigned)tok * 2u + 1u, __ATOMIC_RELAXED, __HIP_MEMORY_SCOPE_AGENT);
        int* TE = (int*)(ws + OFF_TE); int* TP = (int*)(ws + OFF_TP); float* TW = (float*)(ws + OFF_TW);
        TE[tok * 2] = ex1; TE[tok * 2 + 1] = ex2; TP[tok * 2] = (int)p1; TP[tok * 2 + 1] = (int)p2; TW[tok * 2] = w1; TW[tok * 2 + 1] = w2;
        ((float*)(ws + OFF_RSTD2))[tok] = rstd;
    }
}

DEV void build_tb(const Params& p, LDS int* tb) {
    if (threadIdx.x == 0) { const unsigned* cnt = (const unsigned*)(p.ws + OFF_CNT); int a = 0;
        for (int e = 0; e < 64; ++e) { tb[e] = a; const int n = (int)((cnt[e] + 255u) >> 8); for (int t = 0; t < n; ++t) tb[128 + a + t] = e; a += n; }
        tb[64] = a; }
    __syncthreads();
}

extern __shared__ __attribute__((aligned(16))) unsigned char smem_raw[];
__global__ void __launch_bounds__(512, 2) hymba_fwd(Params p) {
    __shared__ uint4 xb_words;
    if (threadIdx.x == 0) xb_words = make_uint4(0u, 0u, 0u, 0u);
    __syncthreads();
    unsigned char* ws = p.ws;
    (void)xcd_barrier_post((unsigned*)(ws + OFF_BAR), (volatile LAS unsigned*)&xb_words);
#if DBG_XBAR
#define GRID_BAR() do { xcd_barrier((unsigned*)(p.ws + OFF_BAR), (volatile LAS unsigned*)&xb_words); xcd_barrier((unsigned*)(p.ws + OFF_BAR), (volatile LAS unsigned*)&xb_words); } while (0)
#else
#define GRID_BAR() xcd_barrier((unsigned*)(p.ws + OFF_BAR), (volatile LAS unsigned*)&xb_words)
#endif
    LDSP lds = (LDSP)smem_raw;
    const int bid = blockIdx.x, xcd = bid & 7, ci = bid >> 3;
#define PHASE_IDS const int tid = opaque((int)threadIdx.x), lane = tid & 63, wid = __builtin_amdgcn_readfirstlane(tid >> 6); LDSP vl = lds + wid * 16384; (void)lane; (void)vl;

#if SKEL < 2
    REPS(0) if (!SKEL) p0_prologue(p, lds);
    GRID_BAR();

    REPS(1) if (!SKEL) {
        const OrderXcd S{(const char*)(ws + OFF_R1), (const char*)(ws + OFF_WINT), (size_t)256 * 1024 * 2, (size_t)256 * 1024 * 2, 12, 12, xcd, ci};
        pg::gemm_phase<EpiInProj, OrderXcd, true, false>(lds, 1024, 1024, S, EpiInProj{ws});
    }
    GRID_BAR();

    REPS(20) if (!SKEL && bid < 64) {
        const int kv = bid & 1, mt = bid >> 1;
        { OrderOne S{}; S.u.a = (const char*)(ws + OFF_KV6 + (size_t)kv * 16 * MB) + (size_t)mt * 256 * 1024 * 2; S.u.b = (const char*)(ws + OFF_WC1T) + (size_t)kv * 256 * 2048 * 2; S.u.pm = mt; S.u.pn = 0; S.u.x0 = 0; S.u.x1 = 0; S.u.x2 = 0;
          pg::gemm_phase<EpiCmp1, OrderOne, false, false>(lds, 2048, 1024, S, EpiCmp1{ws, kv}); }
        asm volatile("s_waitcnt vmcnt(0)" ::: "memory");
        __syncthreads();
        { OrderOne S{}; S.u.a = (const char*)(ws + OFF_HID) + ((size_t)kv * 8192 + (size_t)mt * 256) * 256 * 2; S.u.b = (const char*)(ws + OFF_WC2T) + (size_t)kv * 256 * 256 * 2; S.u.pm = mt; S.u.pn = 0; S.u.x0 = 0; S.u.x1 = 0; S.u.x2 = 0;
          pg::gemm_phase<EpiCmp2, OrderOne, false, false>(lds, 256, 256, S, EpiCmp2{ws, kv}); }
    }
#if EN_DIL
    REPS(2) if (!SKEL) { PHASE_IDS
        unsigned* qbase = (unsigned*)(ws + OFF_QUEUE) + 512 * rep_;
        const int x0 = (int)xb_xcc_id() & 7;
        for (int dq = 0; dq < 8; ++dq) { const int x = (x0 + dq) & 7; unsigned* ctr = qbase + x * 16;
            for (;;) { const unsigned t = wave_pull(ctr, lane); if (t >= 3072u) break; dilated_pair(p, x * 3072 + (int)t, vl, opaque(lane)); } }
    }
#endif
    GRID_BAR();

    if (!SKEL) { PHASE_IDS
#if EN_DIL
    merge_tokens(p, lane, wid);
#else
    for (int tok = bid * 8 + wid; tok < T_TOK; tok += 2048) *(u32x4*)((bf16_t*)(ws + OFF_R1) + (size_t)tok * 1024 + lane * 8) = (u32x4){0u, 0u, 0u, 0u};
#endif
    }
    REPS(3) if (!SKEL) { PHASE_IDS
#if EN_NSA
        const int x0 = (int)xb_xcc_id() & 7;
        { unsigned* qbase = (unsigned*)(ws + OFF_QUEUE) + 384;
          for (int dq = 0; dq < 8; ++dq) { const int x = (x0 + dq) & 7; unsigned* ctr = qbase + x * 16;
            for (;;) { const unsigned t = wave_pull(ctr, lane); if (t >= 512u) break; nsa_sel_task(p, 63 - (int)(t & 63u), 8 * x + (int)(t >> 6), opaque(lane)); } } }
        GRID_BAR();
        { unsigned* qbase = (unsigned*)(ws + OFF_QUEUE) + 256 + 512 * rep_;
          LDS unsigned* tw = (LDS unsigned*)(lds + 32768 + 64);
          for (int dq = 0; dq < 8; ++dq) { const int x = (x0 + dq) & 7; unsigned* ctr = qbase + x * 16;
            for (;;) { if (tid == 0) tw[0] = __hip_atomic_fetch_add(ctr, 1u, __ATOMIC_RELAXED, __HIP_MEMORY_SCOPE_AGENT);
                wg_sync(); const unsigned t = tw[0]; wg_sync();
                if (t >= 256u) break;
                nsa_wg_task(p, 31 - (int)(t & 31u), 8 * x + (int)(t >> 5), lds, tid, opaque(lane), wid); } } }
#else
    for (int tok = bid * 8 + wid; tok < T_TOK; tok += 2048) *(u32x4*)((bf16_t*)(ws + OFF_R1) + (size_t)tok * 1024 + 512 + lane * 8) = (u32x4){0u, 0u, 0u, 0u};
#endif
    }
    GRID_BAR();

    REPS(4) if (!SKEL) {
        const OrderXcd S{(const char*)(ws + OFF_R1), (const char*)(ws + OFF_WOT), (size_t)256 * 1024 * 2, (size_t)256 * 1024 * 2, 4, 4, xcd, ci};
        pg::gemm_phase<EpiOut, OrderXcd, true, false>(lds, 1024, 1024, S, EpiOut{ws, p.x});
    }
    GRID_BAR();

#endif
    LDS int* tb = (LDS int*)(lds + LDS_TB); (void)tb;
#if EN_MOE && !SKEL
    { PHASE_IDS
    router_wave(p, (bid * 8 + wid) * 32, lane, wid, lds); }
    GRID_BAR();

    build_tb(p, tb);
    REPS(6) {
        const OrderMoe1 S{(const char*)(ws + OFF_X1B), (const char*)(ws + OFF_WGUT), (const unsigned*)(ws + OFF_LIST), (const unsigned*)(ws + OFF_CNT), (LDS const int*)tb, tb[64], bid};
#ifndef NO_P6
        pg::gemm_phase<EpiMoe1, OrderMoe1, true, true>(lds, 1024, 1024, S, EpiMoe1{ws});
#endif
    }
    GRID_BAR();

    REPS(7) {
        const OrderMoe2 S{(const char*)(ws + OFF_HE), (const char*)(ws + OFF_WDT), (LDS const int*)tb, tb[64], bid};
#ifndef NO_P7
        pg::gemm_phase<EpiMoe2, OrderMoe2, true, false>(lds, 256, 256, S, EpiMoe2{ws});
#endif
    }
    GRID_BAR();
#endif

    REPS(8) { PHASE_IDS
        const bf16_t* XB = (const bf16_t*)(ws + OFF_X1B); const bf16_t* Y = (const bf16_t*)(ws + OFF_Y);
        const int* TE = (const int*)(ws + OFF_TE); const int* TP = (const int*)(ws + OFF_TP); const float* TW = (const float*)(ws + OFF_TW);
        f32x4 gf[4];
#pragma unroll
        for (int i = 0; i < 4; ++i) gf[i] = *(const f32x4*)(p.norm_f_g + i * 256 + lane * 4);
        int tok = bid * 8 + wid;
        u32x2 te[2], tp[2]; f32x2 tw[2];
#pragma unroll
        for (int j = 0; j < 2; ++j) { const int t = tok + 2048 * j; te[j] = *(const u32x2*)(TE + t * 2); tp[j] = *(const u32x2*)(TP + t * 2); tw[j] = *(const f32x2*)(TW + t * 2); }
        for (; tok < T_TOK; tok += 4096) {
            u32x2 xa[2][4], ya[2][4], yb[2][4];
#pragma unroll
            for (int j = 0; j < 2; ++j) { const int t = tok + 2048 * j;
                const bf16_t* y0 = Y + (size_t)(tb[te[j].x] * 256 + (int)tp[j].x) * 1024; const bf16_t* y1 = Y + (size_t)(tb[te[j].y] * 256 + (int)tp[j].y) * 1024;
#pragma unroll
                for (int i = 0; i < 4; ++i) { const int c = i * 256 + lane * 4; xa[j][i] = *(const u32x2*)(XB + (size_t)t * 1024 + c); ya[j][i] = *(const u32x2*)(y0 + c); yb[j][i] = *(const u32x2*)(y1 + c); } }
            f32x2 twc[2] = {tw[0], tw[1]};
            { const int tn = tok + 4096 < T_TOK ? tok + 4096 : tok;
#pragma unroll
              for (int j = 0; j < 2; ++j) { const int t = tn + 2048 * j; te[j] = *(const u32x2*)(TE + t * 2); tp[j] = *(const u32x2*)(TP + t * 2); tw[j] = *(const f32x2*)(TW + t * 2); } }
#pragma unroll
            for (int j = 0; j < 2; ++j) { const int t = tok + 2048 * j; const float w0 = twc[j].x, w1 = twc[j].y;
                float v[16]; float ss = 0.f;
#pragma unroll
                for (int i = 0; i < 4; ++i) {
                    v[4 * i] = bf_lo(xa[j][i].x) + w0 * bf_lo(ya[j][i].x) + w1 * bf_lo(yb[j][i].x); v[4 * i + 1] = bf_hi(xa[j][i].x) + w0 * bf_hi(ya[j][i].x) + w1 * bf_hi(yb[j][i].x);
                    v[4 * i + 2] = bf_lo(xa[j][i].y) + w0 * bf_lo(ya[j][i].y) + w1 * bf_lo(yb[j][i].y); v[4 * i + 3] = bf_hi(xa[j][i].y) + w0 * bf_hi(ya[j][i].y) + w1 * bf_hi(yb[j][i].y);
                    ss += v[4 * i] * v[4 * i] + v[4 * i + 1] * v[4 * i + 1] + v[4 * i + 2] * v[4 * i + 2] + v[4 * i + 3] * v[4 * i + 3]; }
#pragma unroll
                for (int o = 32; o > 0; o >>= 1) ss += __shfl_xor(ss, o);
                const float rs = 1.0f / sqrtf(ss * (1.0f / 1024.0f) + EPSN);
#pragma unroll
                for (int i = 0; i < 4; ++i) { const int c = i * 256 + lane * 4;
                    f32x4 o; o[0] = v[4 * i] * rs * gf[i][0]; o[1] = v[4 * i + 1] * rs * gf[i][1]; o[2] = v[4 * i + 2] * rs * gf[i][2]; o[3] = v[4 * i + 3] * rs * gf[i][3];
                    *(f32x4*)(p.out + (size_t)t * 1024 + c) = o; } }
        }
    }
}

extern "C" void kernel_launch(void* const* d_in, const int* in_sizes, int n_in, void* d_out, int out_size, void* d_ws, size_t ws_size, hipStream_t stream) {
    static int grid = 0;
    if (grid == 0) {
        int dev = 0, cus = 0;
        if (hipGetDevice(&dev) != hipSuccess || hipDeviceGetAttribute(&cus, hipDeviceAttributeMultiprocessorCount, dev) != hipSuccess) { grid = -1; return; }
        if (hipFuncSetAttribute((const void*)hymba_fwd, hipFuncAttributeMaxDynamicSharedMemorySize, LDS_TOTAL) != hipSuccess) { grid = -1; return; }
        int per_cu = 0;
        (void)hipOccupancyMaxActiveBlocksPerMultiprocessor(&per_cu, (const void*)hymba_fwd, 512, LDS_TOTAL);
        (void)hipGetLastError();
        grid = cus < 256 ? cus : 256;
    }
    if (grid < 0) return;
    (void)hipMemsetAsync(d_ws, 0, CTL_ZERO, stream);
    Params p{};
    p.x = (const float*)d_in[0]; p.norm1_g = (const float*)d_in[1]; p.w_in = (const float*)d_in[2]; p.pe_kc = (const float*)d_in[3]; p.w_kc1 = (const float*)d_in[4]; p.w_kc2 = (const float*)d_in[5];
    p.pe_vc = (const float*)d_in[6]; p.w_vc1 = (const float*)d_in[7]; p.w_vc2 = (const float*)d_in[8]; p.w_o = (const float*)d_in[9]; p.norm2_g = (const float*)d_in[10];
    p.w_rg = (const float*)d_in[11]; p.b_rg = (const float*)d_in[12]; p.w_re = (const float*)d_in[13]; p.b_re = (const float*)d_in[14]; p.w_gate = (const float*)d_in[15]; p.w_up = (const float*)d_in[16]; p.w_down = (const float*)d_in[17]; p.norm_f_g = (const float*)d_in[18];
    p.out = (float*)d_out; p.ws = (unsigned char*)d_ws;
    hipLaunchKernelGGL(hymba_fwd, dim3(grid), dim3(512), LDS_TOTAL, stream, p);
}
```

```cpp
#include <hip/hip_runtime.h>
#include <stdint.h>
#include <math.h>

#ifndef EN_DIL
#define EN_DIL 1
#endif
#ifndef EN_NSA
#define EN_NSA 1
#endif
#ifndef EN_MOE
#define EN_MOE 1
#endif
#ifndef DBG_T1
#define DBG_T1 0
#endif
#ifndef DBG_T2
#define DBG_T2 0
#endif
#ifndef DBG_T3
#define DBG_T3 0
#endif
#ifndef DBG_T4
#define DBG_T4 0
#endif
#ifndef DBG_T5
#define DBG_T5 0
#endif
#ifndef DBG_T6
#define DBG_T6 0
#endif
#ifndef DBG_T8
#define DBG_T8 0
#endif
#ifndef GEMM_SAFE
#define GEMM_SAFE 0
#endif
#ifndef DBG_T9
#define DBG_T9 0
#endif
#ifndef DBG_TA
#define DBG_TA 0
#endif
#ifndef REP_PHASE
#define REP_PHASE -1
#endif
#define REPS(k) for (int rep_ = 0; rep_ < ((REP_PHASE == (k)) ? 2 : 1); ++rep_)
#ifndef DBG_LDSPOISON
#define DBG_LDSPOISON 0
#endif
#ifndef DBG_XBAR
#define DBG_XBAR 0
#endif
#ifndef SKEL
#define SKEL 0
#endif

#define DEV __device__ __forceinline__
#define LDS __attribute__((address_space(3)))
typedef LDS unsigned char* LDSP;
typedef unsigned short bf16_t;
typedef short bf16x8 __attribute__((ext_vector_type(8)));
typedef short s16x4 __attribute__((ext_vector_type(4)));
typedef float f32x16 __attribute__((ext_vector_type(16)));
typedef float f32x4 __attribute__((ext_vector_type(4)));
typedef unsigned u32x4 __attribute__((ext_vector_type(4)));
typedef unsigned u32x2 __attribute__((ext_vector_type(2)));
typedef float f32x2 __attribute__((ext_vector_type(2)));

#define MFMA32(a, b, c) __builtin_amdgcn_mfma_f32_32x32x16_bf16(a, b, c, 0, 0, 0)

constexpr int T_TOK = 65536, SEQ = 2048, DM = 1024;
constexpr int NPROJ = 2840, NPAD = 3072;
constexpr float SCQ = 0.125f * 1.4426950408889634f;
constexpr float EPSN = 1e-6f;

constexpr size_t MB = 1048576;
constexpr size_t OFF_BAR = 0, OFF_QUEUE = 28672, OFF_CNT = 20480, OFF_BIAS1 = 24576, CTL_ZERO = 32768;
constexpr size_t OFF_ROPEC = 1 * MB, OFF_ROPES = 1 * MB + 65536;
constexpr size_t OFF_SEL = 1 * MB + 131072;
constexpr size_t OFF_WINT = 2 * MB;
constexpr size_t OFF_WOT = OFF_WINT + (size_t)NPAD * 1024 * 2;
constexpr size_t OFF_WC1T = OFF_WOT + (size_t)1024 * 1024 * 2;
constexpr size_t OFF_WC2T = OFF_WC1T + (size_t)2 * 256 * 2048 * 2;
constexpr size_t OFF_WRT = OFF_WC2T + (size_t)2 * 256 * 256 * 2;
constexpr size_t OFF_WGUT = OFF_WRT + (size_t)2 * 128 * 1024 * 2;
constexpr size_t OFF_WDT = OFF_WGUT + (size_t)64 * 512 * 1024 * 2;
constexpr size_t OFF_LIST = OFF_WDT + (size_t)64 * 1024 * 256 * 2;
constexpr size_t OFF_TE = OFF_LIST + (size_t)64 * 65536 * 4;
constexpr size_t OFF_TP = OFF_TE + (size_t)T_TOK * 2 * 4;
constexpr size_t OFF_TW = OFF_TP + (size_t)T_TOK * 2 * 4;
constexpr size_t OFF_RSTD2 = OFF_TW + (size_t)T_TOK * 2 * 4;
constexpr size_t OFF_WEND = OFF_RSTD2 + (size_t)T_TOK * 4;
constexpr size_t OFF_R1 = 136 * MB;
constexpr size_t OFF_R2 = 264 * MB;
constexpr size_t OFF_QA = OFF_R2, OFF_KA = OFF_R2 + 64 * MB, OFF_VA = OFF_R2 + 128 * MB, OFF_QB = OFF_R2 + 192 * MB;
constexpr size_t OFF_KV6 = OFF_R2 + 256 * MB;
constexpr size_t OFF_GATE = OFF_R2 + 352 * MB;
constexpr size_t OFF_R3 = 622 * MB;
constexpr size_t OFF_OP = OFF_R3;
constexpr size_t OFF_LSE = OFF_R3 + 192 * MB;
constexpr size_t OFF_HID = OFF_R3 + 198 * MB;
constexpr size_t OFF_KC = OFF_R3 + 206 * MB;
constexpr size_t OFF_VC = OFF_R3 + 207 * MB;
constexpr size_t OFF_X1B = OFF_R2, OFF_X1L = OFF_R2 + 128 * MB;
constexpr size_t OFF_HE = OFF_R1;
constexpr size_t OFF_Y = OFF_R2 + 256 * MB;
static_assert(OFF_WEND <= OFF_R1, "weights region overflow");
static_assert(OFF_Y + (size_t)147456 * 1024 * 2 <= OFF_HID, "Y overlaps live data");

constexpr int LDS_GEMM = 131072;
constexpr int LDS_TB = LDS_GEMM;
constexpr int LDS_TOTAL = LDS_GEMM + 4096;

struct Params {
    const float* x; const float* norm1_g; const float* w_in; const float* pe_kc; const float* w_kc1; const float* w_kc2;
    const float* pe_vc; const float* w_vc1; const float* w_vc2; const float* w_o; const float* norm2_g;
    const float* w_rg; const float* b_rg; const float* w_re; const float* b_re; const float* w_gate; const float* w_up; const float* w_down; const float* norm_f_g;
    float* out; unsigned char* ws;
};

typedef __bf16 bf16v2 __attribute__((ext_vector_type(2)));
DEV unsigned cvt_pk(float lo, float hi) { bf16v2 v; v.x = (__bf16)lo; v.y = (__bf16)hi; return __builtin_bit_cast(unsigned, v); }
DEV float bf_lo(unsigned u) { return __uint_as_float(u << 16); }
DEV float bf_hi(unsigned u) { return __uint_as_float(u & 0xffff0000u); }
DEV float fexp2(float x) { return __builtin_amdgcn_exp2f(x); }
DEV int perm32(int rho) { const int g = rho >> 3, h = (rho >> 2) & 1, e = rho & 3; return 16 * (g >> 1) + 8 * h + 4 * (g & 1) + e; }
DEV int rope_src(int i) { return i < 16 ? ((i & 1) ? 8 + (i >> 1) : (i >> 1)) : i; }
DEV float xhalf_max(float v) { auto r = __builtin_amdgcn_permlane32_swap(__float_as_uint(v), __float_as_uint(v), false, false); return fmaxf(__uint_as_float(r[0]), __uint_as_float(r[1])); }
DEV float xhalf_sum(float v) { auto r = __builtin_amdgcn_permlane32_swap(__float_as_uint(v), __float_as_uint(v), false, false); return __uint_as_float(r[0]) + __uint_as_float(r[1]); }
DEV int opaque(int v) { asm volatile("" : "+v"(v)); return v; }
DEV int lds_off(int row, int chunk) { return row * 128 + ((chunk ^ ((row >> 1) & 7)) << 4); }

#define XB_TMO      128
#define XB_XCNT(j)  (256  + 64 * (j))
#define XB_XSUB(j)  (1280 + 64 * (j))
#define XB_XGEN(j)  (2304 + 64 * (j))
#define XB_TOP      3328
#define XB_TOPGEN   3392
#define XCD_BAR_WORDS 3456
#define XB_SPIN_CAP (1u << 18)
#define LAS __attribute__((address_space(3)))

__device__ __forceinline__ unsigned xb_ld(unsigned* p)              { return __hip_atomic_load(p, __ATOMIC_RELAXED, __HIP_MEMORY_SCOPE_AGENT); }
__device__ __forceinline__ unsigned xb_add(unsigned* p, unsigned v) { return __hip_atomic_fetch_add(p, v, __ATOMIC_RELAXED, __HIP_MEMORY_SCOPE_AGENT); }
__device__ __forceinline__ unsigned xb_xcc_id() { return (unsigned)__builtin_amdgcn_s_getreg((3 << 11) | 20) & 0xFu; }
#define XB_SPIN(cond, bar) do { unsigned _sp = 0; while (cond) { __builtin_amdgcn_s_sleep(1); \
    if ((++_sp & 255u) == 0u) { if (xb_ld(&(bar)[XB_TMO])) break; if (_sp > XB_SPIN_CAP) { atomicAdd(&(bar)[XB_TMO], 1u); break; } } } } while (0)

struct XcdBarrier { unsigned* bar; unsigned x; volatile LAS unsigned* st; };

__device__ __forceinline__ XcdBarrier xcd_barrier_post(unsigned* bar, volatile LAS unsigned* st) {
    XcdBarrier b; b.bar = bar; b.x = xb_xcc_id(); b.st = st;
    if (threadIdx.x == 0) (void)xb_add(&bar[XB_XCNT(b.x)], 1u);
    return b;
}
__device__ __forceinline__ void xcd_barrier_complete(unsigned* bar, unsigned x, unsigned& nloc, unsigned& nx) {
    const unsigned G = gridDim.x * gridDim.y * gridDim.z;
    unsigned sum, cnt, mine, sp = 0u;
    for (;;) {
        sum = 0u; cnt = 0u; mine = 0u;
#pragma unroll
        for (unsigned j = 0; j < 16; ++j) { const unsigned c = xb_ld(&bar[XB_XCNT(j)]); sum += c; cnt += (c > 0u) ? 1u : 0u; mine = (j == x) ? c : mine; }
        if (sum == G) break;
        __builtin_amdgcn_s_sleep(1);
        if ((++sp & 255u) == 0u) { if (xb_ld(&bar[XB_TMO])) break; if (sp > XB_SPIN_CAP) { atomicAdd(&bar[XB_TMO], 1u); break; } }
    }
    nloc = mine > 0u ? mine : 1u; nx = cnt > 0u ? cnt : 1u;
}
__device__ __forceinline__ void xcd_barrier_impl(const XcdBarrier& b) {
    asm volatile("s_waitcnt vmcnt(0)" ::: "memory");
    __syncthreads();
    if (threadIdx.x == 0) {
        unsigned* bar = b.bar;
        __builtin_amdgcn_s_waitcnt(0);
        unsigned nloc = b.st[0], nx = b.st[1];
        if (nloc == 0u) { xcd_barrier_complete(bar, b.x, nloc, nx); b.st[0] = nloc; b.st[1] = nx; }
        const unsigned old = xb_add(&bar[XB_XSUB(b.x)], 1u);
        const unsigned gen = old / nloc;
        if (old + 1u == (gen + 1u) * nloc) {
            __builtin_amdgcn_fence(__ATOMIC_RELEASE, "agent");
            asm volatile("s_waitcnt vmcnt(0)" ::: "memory");
            const unsigned og = xb_add(&bar[XB_TOP], 1u);
            const unsigned tg = og / nx;
            if (og + 1u == (tg + 1u) * nx) xb_add(&bar[XB_TOPGEN], 1u);
            else XB_SPIN(xb_ld(&bar[XB_TOPGEN]) == tg, bar);
            __builtin_amdgcn_fence(__ATOMIC_ACQUIRE, "agent");
            xb_add(&bar[XB_XGEN(b.x)], 1u);
            asm volatile("s_waitcnt vmcnt(0)" ::: "memory");
        } else {
            XB_SPIN(xb_ld(&bar[XB_XGEN(b.x)]) == gen, bar);
            __builtin_amdgcn_fence(__ATOMIC_ACQUIRE, "agent");
            asm volatile("s_waitcnt vmcnt(0)" ::: "memory");
        }
    }
    __syncthreads();
}

DEV void xcd_barrier(unsigned* barw, volatile LAS unsigned* st) { XcdBarrier b; b.bar = barw; b.x = xb_xcc_id(); b.st = st; xcd_barrier_impl(b); }

template <class F>
DEV void tr_matrix(const F f, bf16_t* dst, int NR, int K, int lomode, LDSP lds) {
    LDS float* tile = (LDS float*)lds;
    const int tid = threadIdx.x, tk = K >> 6, nt = (NR >> 6) * tk;
    for (int t = blockIdx.x; t < nt; t += gridDim.x) {
        const int n0 = (t / tk) << 6, k0 = (t % tk) << 6;
#pragma unroll
        for (int i = 0; i < 8; ++i) { const int kk = (tid >> 6) + 8 * i, nn = tid & 63; tile[kk * 65 + nn] = f(n0 + nn, k0 + kk); }
        __syncthreads();
        {
            const int nn = tid >> 3, k8 = (tid & 7) * 8; float v[8];
#pragma unroll
            for (int j = 0; j < 8; ++j) { v[j] = tile[(k8 + j) * 65 + nn]; if (lomode) v[j] = v[j] - bf_lo(cvt_pk(v[j], 0.f) & 0xffffu); }
            u32x4 w; w.x = cvt_pk(v[0], v[1]); w.y = cvt_pk(v[2], v[3]); w.z = cvt_pk(v[4], v[5]); w.w = cvt_pk(v[6], v[7]);
            *(u32x4*)(dst + (size_t)(n0 + nn) * K + k0 + k8) = w;
        }
        __syncthreads();
    }
}
struct SrcWin { const float* w; const float* g1;
    DEV float operator()(int R, int k) const {
        const int c = R;
        if (c >= NPROJ) return 0.f;
        const bool rp = (c < 1024) || (c >= 1536 && c < 2048) || (c >= 2304 && c < 2432) || (c >= 2560 && c < 2688);
        const int src = rp ? (c & ~63) + rope_src(c & 63) : c;
        const float sc = (c < 512 || (c >= 1536 && c < 2048)) ? SCQ : 1.f;
        return w[(size_t)k * NPROJ + src] * g1[k] * sc; } };
struct SrcWo { const float* w; DEV float operator()(int R, int k) const { return w[(size_t)k * 1024 + R]; } };
DEV const float* psel(const float* a, const float* b, int pick_b) { return (const float*)((uintptr_t)a + (pick_b ? ((uintptr_t)b - (uintptr_t)a) : (uintptr_t)0)); }
struct SrcWc1 { const float* wk; const float* wv; DEV float operator()(int R, int k) const { const float* w = psel(wk, wv, R >> 8); const int r = R & 255; return w[(size_t)k * 256 + r]; } };
struct SrcWc2 { const float* wk; const float* wv;
    DEV float operator()(int R, int k) const { const int kv = R >> 8, r = R & 255, c = r; if (c >= 64) return 0.f;
        return psel(wk, wv, kv)[(size_t)k * 64 + (kv ? c : rope_src(c))]; } };
struct SrcWr { const float* wrg; const float* wre; const float* g2;
    DEV float operator()(int R, int k) const { if (R >= 96) return 0.f; const int c = (R & ~31) + perm32(R & 31), lb = c >> 3, ix = c & 7;
        if (lb > 8) return 0.f; const size_t off = lb == 0 ? (size_t)k * 8 + ix : (size_t)k * 64 + (lb - 1) * 8 + ix; return psel(wrg, wre, lb != 0)[off] * g2[k]; } };
struct SrcWgu { const float* wg; const float* wu; const float* g2;
    DEV float operator()(int R, int k) const { const int e = R >> 9, r = R & 511, pn = r >> 8, bj = (r >> 7) & 1, j = pn * 128 + (r & 127);
        const float* w = psel(wg, wu, bj); return w[((size_t)e * 1024 + k) * 256 + j] * g2[k]; } };
struct SrcWd { const float* w; DEV float operator()(int R, int k) const { const int e = R >> 10, r = R & 1023; return w[((size_t)e * 256 + k) * 1024 + r]; } };

DEV void p0_prologue(const Params& p, LDSP lds) {
    unsigned char* ws = p.ws;
    const int tid = threadIdx.x, lane = tid & 63, wid = tid >> 6, bid = blockIdx.x;
    { const int idx = bid * 512 + tid; if (idx < 2048 * 8) { const int pos = idx >> 3, pp = idx & 7;
        const float invf = (float)pow(500000.0, -(double)pp / 8.0); const float ang = (float)pos * invf;
        ((float*)(ws + OFF_ROPEC))[idx] = (float)cos((double)ang); ((float*)(ws + OFF_ROPES))[idx] = (float)sin((double)ang); } }
    if (bid < 16) { const int kv = bid & 1, jb = (bid >> 1) * 32, j = jb + (tid & 31), part = tid >> 5; const float* pe = psel(p.pe_kc, p.pe_vc, kv); const float* w1 = psel(p.w_kc1, p.w_vc1, kv);
        float a = 0.f; const int k0 = part * 128;
        for (int kk = k0; kk < k0 + 128; ++kk) a += pe[kk] * w1[(size_t)kk * 256 + j];
        LDS float* red = (LDS float*)lds; red[part * 32 + (tid & 31)] = a;
        __syncthreads();
        if (tid < 32) { float t = 0.f; for (int q = 0; q < 16; ++q) t += red[q * 32 + tid]; ((float*)(ws + OFF_BIAS1))[kv * 256 + jb + tid] = t; }
        __syncthreads(); }
    { bf16_t* HB = (bf16_t*)(ws + OFF_R1);
      for (int row = bid * 8 + wid; row < T_TOK; row += 8192) {
        f32x4 v[4][4]; float ss[4];
#pragma unroll
        for (int j = 0; j < 4; ++j) { const float* xr = p.x + (size_t)(row + 2048 * j) * 1024;
#pragma unroll
          for (int i = 0; i < 4; ++i) v[j][i] = *(const f32x4*)(xr + i * 256 + lane * 4); }
#pragma unroll
        for (int j = 0; j < 4; ++j) { ss[j] = 0.f;
#pragma unroll
          for (int i = 0; i < 4; ++i) ss[j] += v[j][i][0] * v[j][i][0] + v[j][i][1] * v[j][i][1] + v[j][i][2] * v[j][i][2] + v[j][i][3] * v[j][i][3]; }
#pragma unroll
        for (int o = 32; o > 0; o >>= 1) {
#pragma unroll
          for (int j = 0; j < 4; ++j) ss[j] += __shfl_xor(ss[j], o); }
#pragma unroll
        for (int j = 0; j < 4; ++j) { const float rs = 1.0f / sqrtf(ss[j] * (1.0f / 1024.0f) + EPSN);
#pragma unroll
          for (int i = 0; i < 4; ++i) { u32x2 w; w.x = cvt_pk(v[j][i][0] * rs, v[j][i][1] * rs); w.y = cvt_pk(v[j][i][2] * rs, v[j][i][3] * rs); *(u32x2*)(HB + (size_t)(row + 2048 * j) * 1024 + i * 256 + lane * 4) = w; } }
      } }
    tr_matrix(SrcWin{p.w_in, p.norm1_g}, (bf16_t*)(ws + OFF_WINT), NPAD, 1024, 0, lds);
    tr_matrix(SrcWo{p.w_o}, (bf16_t*)(ws + OFF_WOT), 1024, 1024, 0, lds);
    tr_matrix(SrcWc1{p.w_kc1, p.w_vc1}, (bf16_t*)(ws + OFF_WC1T), 512, 2048, 0, lds);
    tr_matrix(SrcWc2{p.w_kc2, p.w_vc2}, (bf16_t*)(ws + OFF_WC2T), 512, 256, 0, lds);
    tr_matrix(SrcWr{p.w_rg, p.w_re, p.norm2_g}, (bf16_t*)(ws + OFF_WRT), 128, 1024, 0, lds);
    tr_matrix(SrcWr{p.w_rg, p.w_re, p.norm2_g}, (bf16_t*)(ws + OFF_WRT) + 128 * 1024, 128, 1024, 1, lds);
    tr_matrix(SrcWgu{p.w_gate, p.w_up, p.norm2_g}, (bf16_t*)(ws + OFF_WGUT), 64 * 512, 1024, 0, lds);
    tr_matrix(SrcWd{p.w_down}, (bf16_t*)(ws + OFF_WDT), 64 * 1024, 256, 0, lds);
}

#define GLDS16(src, dstoff) __builtin_amdgcn_global_load_lds((const unsigned*)(src), (LDS unsigned*)(lds + (dstoff)), 16, 0, 0)
namespace pg {
constexpr int BM = 256, BK = 64, HALF = 128, HTB = HALF * BK * 2, STAGE_BYTES = 8 * HTB;
DEV int lds_byte(int r, int c) { const int st = (r >> 4) * 2 + (c >> 5), rr = r & 15, cc = c & 31, ob = rr * 64 + cc * 2; return st * 1024 + (ob ^ (((ob >> 9) & 1) << 5)); }
DEV void stage_rc(int b, int& R, int& C) { const int st = b / 1024, sb = b % 1024, swz = sb ^ (((sb >> 9) & 1) << 5); R = (st >> 1) * 16 + swz / 64; C = (st & 1) * 32 + (swz % 64) / 2; }
DEV int pg_perm32(int rho) { const int n = rho >> 4, i = rho & 15; return 8 * (i >> 2) + 4 * n + (i & 3); }
struct Unit { const char* a; const char* b; int pm, pn, x0, x1, x2; };
typedef f32x4 Acc[2][2][4][2];

template <class Epi, class Sched, bool ALIGN_EPI, bool GATHER>
DEV void gemm_phase(LDSP lds, int K_, int lda, const Sched& S, const Epi& E) {
    int K = K_; asm volatile("" : "+s"(K));
    const int tid = opaque((int)threadIdx.x), wid = __builtin_amdgcn_readfirstlane(tid >> 6), lane = tid & 63, wr = wid >> 2, wc = wid & 3, fr = lane & 15, fq = lane >> 4;
    const int nt = K / BK;
    Unit cur, nxt; int ui = 0;
    if (!S.next(0, cur)) return;
    unsigned voffA0[2], voffA1[2], voffB[2], nvA0[2], nvA1[2]; int sR[2], sC[2];
#pragma unroll
    for (int i = 0; i < 2; ++i) { int R, C; stage_rc(tid * 16 + i * 8192, R, C); sR[i] = R; sC[i] = C; const int Rb = (R & ~31) + pg_perm32(R & 31);
        if constexpr (GATHER) { voffA0[i] = (S.arow(cur, R) + (unsigned)C) * 2u; voffA1[i] = (S.arow(cur, R + HALF) + (unsigned)C) * 2u; }
        else { voffA0[i] = (unsigned)(R * lda + C) * 2u; voffA1[i] = (unsigned)((R + HALF) * lda + C) * 2u; }
        nvA0[i] = voffA0[i]; nvA1[i] = voffA1[i];
        voffB[i] = (unsigned)(Rb * K + C) * 2u; }
    const size_t kstep = (size_t)(BK * 2);
    const size_t hstepB = (size_t)HALF * K * 2;
    const unsigned ldsw = (unsigned)wid * 1024u;
    const int aoff = lds_byte(wr * 64 + fr, fq * 8), boff = lds_byte(wc * 32 + fr, fq * 8);
#define PG_SA(b, h) (((b) * 2 + (h)) * HTB)
#define PG_SB(b, h) ((4 + (b) * 2 + (h)) * HTB)
#define PG_STAGE(bufoff, gbase, voff) do { _Pragma("unroll") for (int _i = 0; _i < 2; ++_i) GLDS16((const char*)(gbase) + (voff)[_i], (bufoff) + ldsw + _i * 8192); } while (0)
#define PG_LDA(dst, b, h) do { _Pragma("unroll") for (int m = 0; m < 4; ++m) _Pragma("unroll") for (int k = 0; k < 2; ++k) dst[m][k] = *(const LDS bf16x8*)(lds + PG_SA(b, h) + aoff + m * 2048 + k * 1024); } while (0)
#define PG_LDB(dst, b, h) do { _Pragma("unroll") for (int n = 0; n < 2; ++n) _Pragma("unroll") for (int k = 0; k < 2; ++k) dst[n][k] = *(const LDS bf16x8*)(lds + PG_SB(b, h) + boff + n * 2048 + k * 1024); } while (0)
#define PG_MMA(ai, bj, At, Bt) do { __builtin_amdgcn_s_setprio(1); _Pragma("unroll") for (int m = 0; m < 4; ++m) _Pragma("unroll") for (int n = 0; n < 2; ++n) _Pragma("unroll") for (int k = 0; k < 2; ++k) \
        acc[ai][bj][m][n] = __builtin_amdgcn_mfma_f32_16x16x32_bf16(Bt[n][k], At[m][k], acc[ai][bj][m][n], 0, 0, 0); __builtin_amdgcn_s_setprio(0); } while (0)
#define PG_WAIT_V(n) asm volatile("s_waitcnt vmcnt(" #n ")" ::: "memory")
#define PG_WAIT_L(n) asm volatile("s_waitcnt lgkmcnt(" #n ")" ::: "memory")
#define PG_BAR __builtin_amdgcn_s_barrier()
#define PG_SCHED __builtin_amdgcn_sched_barrier(0)
    Acc acc;
#pragma unroll
    for (int a = 0; a < 2; ++a)
#pragma unroll
        for (int b = 0; b < 2; ++b)
#pragma unroll
            for (int m = 0; m < 4; ++m)
#pragma unroll
                for (int n = 0; n < 2; ++n) acc[a][b][m][n] = (f32x4){0.f, 0.f, 0.f, 0.f};
    bf16x8 At[4][2], B0[2][2], B1[2][2];
    const char* cA = cur.a; const char* cB = cur.b;
    PG_STAGE(PG_SB(0, 0), cB, voffB); PG_STAGE(PG_SB(0, 1), cB + hstepB, voffB); PG_STAGE(PG_SA(0, 0), cA, voffA0); PG_STAGE(PG_SA(0, 1), cA, voffA1);
    if (wr == 1) PG_BAR;
    PG_WAIT_V(2); PG_BAR;
    PG_STAGE(PG_SB(1, 0), cB + kstep, voffB); PG_STAGE(PG_SA(1, 0), cA + kstep, voffA0); PG_STAGE(PG_SB(1, 1), cB + hstepB + kstep, voffB);
    PG_WAIT_V(6); PG_BAR;
    for (;;) {
        const bool has_next = S.next(ui + 1, nxt);
        const char* nA = has_next ? nxt.a : cA; const char* nB = has_next ? nxt.b : cB;
        if constexpr (GATHER) { if (has_next) {
#pragma unroll
            for (int i = 0; i < 2; ++i) { nvA0[i] = (S.arow(nxt, sR[i]) + (unsigned)sC[i]) * 2u; nvA1[i] = (S.arow(nxt, sR[i] + HALF) + (unsigned)sC[i]) * 2u; } } }
        for (int t = 0; t < nt; t += 2) {
            const bool last = (t == nt - 2);
            const char* a1 = cA + (size_t)(t + 1) * kstep;
            const char* a2 = last ? nA : cA + (size_t)(t + 2) * kstep; const char* b2 = last ? nB : cB + (size_t)(t + 2) * kstep;
            const char* a3 = a2 + kstep; const char* b3 = b2 + kstep;
            unsigned w0[2], w1[2];
#pragma unroll
            for (int i = 0; i < 2; ++i) { w0[i] = (GATHER && last) ? nvA0[i] : voffA0[i]; w1[i] = (GATHER && last) ? nvA1[i] : voffA1[i]; }
            PG_LDB(B0, 0, 0); PG_LDB(B1, 0, 1); PG_SCHED; PG_LDA(At, 0, 0); PG_STAGE(PG_SA(1, 1), a1, voffA1);
            PG_WAIT_V(8); PG_WAIT_L(0); PG_BAR; PG_MMA(0, 0, At, B0); PG_MMA(0, 1, At, B1); PG_BAR; PG_SCHED;
            PG_LDA(At, 0, 1); PG_STAGE(PG_SB(0, 0), b2, voffB); PG_STAGE(PG_SB(0, 1), b2 + hstepB, voffB); PG_STAGE(PG_SA(0, 0), a2, w0);
            PG_WAIT_V(8); PG_WAIT_L(0); PG_BAR; PG_MMA(1, 0, At, B0); PG_MMA(1, 1, At, B1); PG_BAR; PG_SCHED;
            PG_LDB(B0, 1, 0); PG_LDB(B1, 1, 1); PG_SCHED; PG_LDA(At, 1, 0); PG_STAGE(PG_SA(0, 1), a2, w1);
            PG_WAIT_V(8); PG_WAIT_L(0); PG_BAR; PG_MMA(0, 0, At, B0); PG_MMA(0, 1, At, B1); PG_BAR; PG_SCHED;
            PG_LDA(At, 1, 1); PG_STAGE(PG_SB(1, 0), b3, voffB); PG_STAGE(PG_SB(1, 1), b3 + hstepB, voffB); PG_STAGE(PG_SA(1, 0), a3, w0);
            PG_WAIT_V(8); PG_WAIT_L(0); PG_BAR; PG_MMA(1, 0, At, B0); PG_MMA(1, 1, At, B1); PG_BAR; PG_SCHED;
        }
        if constexpr (ALIGN_EPI) { if (wr == 0) PG_BAR; }
        E(acc, cur, wr, wc, fr, fq);
        if (!has_next) break;
#pragma unroll
        for (int a = 0; a < 2; ++a)
#pragma unroll
            for (int b = 0; b < 2; ++b)
#pragma unroll
                for (int m = 0; m < 4; ++m)
#pragma unroll
                    for (int n = 0; n < 2; ++n) acc[a][b][m][n] = (f32x4){0.f, 0.f, 0.f, 0.f};
        cur = nxt; cA = nA; cB = nB; ++ui;
        if constexpr (GATHER) {
#pragma unroll
            for (int i = 0; i < 2; ++i) { voffA0[i] = nvA0[i]; voffA1[i] = nvA1[i]; } }
        if constexpr (ALIGN_EPI) { if (wr == 1) PG_BAR; }
    }
    PG_WAIT_V(0);
    if constexpr (!ALIGN_EPI) { if (wr == 0) PG_BAR; }
    PG_BAR;
#undef PG_SA
#undef PG_SB
#undef PG_STAGE
#undef PG_LDA
#undef PG_LDB
#undef PG_MMA
#undef PG_WAIT_V
#undef PG_WAIT_L
#undef PG_BAR
#undef PG_SCHED
}
}

DEV u32x4 pack8(const float (&v)[8]) { u32x4 w; w.x = cvt_pk(v[0], v[1]); w.y = cvt_pk(v[2], v[3]); w.z = cvt_pk(v[4], v[5]); w.w = cvt_pk(v[6], v[7]); return w; }
#define PACC8(v, acc, ai, bj, m) { _Pragma("unroll") for (int _e = 0; _e < 4; ++_e) { v[_e] = acc[ai][bj][m][0][_e]; v[4 + _e] = acc[ai][bj][m][1][_e]; } }

struct OrderXcd { const char* A; const char* Bt; size_t astep, bstep; int NT, rounds, xcd, ci;
    DEV bool next(int i, pg::Unit& u) const { if (i >= rounds) return false; const int q = i * 32 + ci, per = 4 * NT, mg = q / per, rem = q % per;
        u.pn = rem >> 2; u.pm = xcd * 32 + mg * 4 + (rem & 3); u.a = A + (size_t)u.pm * astep; u.b = Bt + (size_t)u.pn * bstep; u.x0 = 0; u.x1 = 0; u.x2 = 0; return true; } };
struct OrderOne { pg::Unit u;
    DEV bool next(int i, pg::Unit& o) const { if (i) return false; o = u; return true; } };
struct OrderMoe1 { const char* X; const char* WGU; const unsigned* LISTB; const unsigned* cntp; LDS const int* tb; int ntile, bid;
    DEV bool next(int i, pg::Unit& u) const { const int q = bid + 256 * i; if (q >= ntile * 2) return false; const int rt = q >> 1, nt = q & 1, e = __builtin_amdgcn_readfirstlane(tb[128 + rt]);
        u.pm = rt; u.pn = nt; u.x0 = e; u.x1 = (rt - __builtin_amdgcn_readfirstlane(tb[e])) * 256; u.x2 = (int)cntp[e]; u.a = X; u.b = WGU + (size_t)(e * 512 + nt * 256) * 1024 * 2; return true; }
    DEV unsigned arow(const pg::Unit& u, int r) const { const int pos = u.x1 + r; return (pos < u.x2 ? (LISTB[(size_t)u.x0 * 65536 + pos] >> 1) : 0u) * 1024u; } };
struct OrderMoe2 { const char* HE; const char* WDT; LDS const int* tb; int ntile, bid;
    DEV bool next(int i, pg::Unit& u) const { const int q = bid + 256 * i; if (q >= ntile * 4) return false; const int rt = q >> 2, nt = q & 3, e = __builtin_amdgcn_readfirstlane(tb[128 + rt]);
        u.pm = rt; u.pn = nt; u.x0 = e; u.x1 = 0; u.x2 = 0; u.a = HE + (size_t)rt * 256 * 256 * 2; u.b = WDT + (size_t)(e * 1024 + nt * 256) * 256 * 2; return true; } };

struct EpiInProj { unsigned char* ws;
    DEV void operator()(const pg::Acc& acc, const pg::Unit& u, int wr, int wc, int fr, int fq) const {
        const float* rc = (const float*)(ws + OFF_ROPEC); const float* rsn = (const float*)(ws + OFF_ROPES);
        const int tok0 = u.pm * 256 + wr * 64 + fr, b = tok0 >> 11, s0 = tok0 & 2047;
#pragma unroll
        for (int bj = 0; bj < 2; ++bj) {
            const int cu = u.pn * 256 + bj * 128 + wc * 32;
            const int c = cu + 8 * fq;
            if (cu >= 2816) {
                if (c < NPROJ) {
#pragma unroll
                    for (int ai = 0; ai < 2; ++ai)
#pragma unroll
                        for (int m = 0; m < 4; ++m) { const int tok = tok0 + ai * 128 + m * 16; float v[8]; PACC8(v, acc, ai, bj, m);
                            float* g = (float*)(ws + OFF_GATE) + (size_t)tok * 24 + (c - 2816); f32x4 a, d;
#pragma unroll
                            for (int i = 0; i < 4; ++i) { a[i] = 1.f / (1.f + __expf(-v[i])); d[i] = 1.f / (1.f + __expf(-v[4 + i])); }
                            *(f32x4*)g = a; *(f32x4*)(g + 4) = d; } }
                continue;
            }
            size_t base; int head, nh; bool rp;
            if (cu < 2048) { const int reg = cu >> 9; base = OFF_R2 + (size_t)reg * (64 * MB); head = (cu & 511) >> 6; nh = 8; rp = (reg != 2); }
            else { const int reg = (cu - 2048) >> 7; base = OFF_KV6 + (size_t)reg * (16 * MB); head = ((cu - 2048) & 127) >> 6; nh = 2; rp = (reg == 2 || reg == 4); }
            bf16_t* dst0 = (bf16_t*)(ws + base) + ((size_t)(b * nh + head) * 2048 + s0) * 64 + (c & 63);
            if (rp && (cu & 63) == 0) {
                const int p0 = (c & 31) >> 1;
                f32x4 cs[8], sn[8];
#pragma unroll
                for (int q = 0; q < 8; ++q) { const int srow = s0 + (q >> 2) * 128 + (q & 3) * 16; cs[q] = *(const f32x4*)(rc + srow * 8 + (p0 & 4)); sn[q] = *(const f32x4*)(rsn + srow * 8 + (p0 & 4)); }
#pragma unroll
                for (int q = 0; q < 8; ++q) { const int ai = q >> 2, m = q & 3; float v[8]; PACC8(v, acc, ai, bj, m);
                    if (fq < 2) {
#pragma unroll
                        for (int pr = 0; pr < 4; ++pr) { const float x1 = v[2 * pr], x2 = v[2 * pr + 1]; v[2 * pr] = x1 * cs[q][pr] - x2 * sn[q][pr]; v[2 * pr + 1] = x2 * cs[q][pr] + x1 * sn[q][pr]; } }
                    *(u32x4*)(dst0 + (size_t)(ai * 128 + m * 16) * 64) = pack8(v); }
            } else {
#pragma unroll
                for (int q = 0; q < 8; ++q) { const int ai = q >> 2, m = q & 3; float v[8]; PACC8(v, acc, ai, bj, m);
                    *(u32x4*)(dst0 + (size_t)(ai * 128 + m * 16) * 64) = pack8(v); }
            }
        }
    }
};

DEV float gelu_tanh(float x) { const float u = 0.7978845608028654f * (x + 0.044715f * x * x * x); return 0.5f * x * (1.f + tanhf(u)); }
struct EpiCmp1 { unsigned char* ws; int kv;
    DEV void operator()(const pg::Acc& acc, const pg::Unit& u, int wr, int wc, int fr, int fq) const {
        const float* bias = (const float*)(ws + OFF_BIAS1) + kv * 256;
        bf16_t* HID = (bf16_t*)(ws + OFF_HID) + (size_t)kv * 8192 * 256;
#pragma unroll
        for (int ai = 0; ai < 2; ++ai)
#pragma unroll
            for (int m = 0; m < 4; ++m) { const int R = u.pm * 256 + ai * 128 + wr * 64 + m * 16 + fr;
#pragma unroll
                for (int bj = 0; bj < 2; ++bj) { const int n = bj * 128 + wc * 32 + 8 * fq; float v[8]; PACC8(v, acc, ai, bj, m);
#pragma unroll
                    for (int i = 0; i < 8; ++i) v[i] = gelu_tanh(v[i] + bias[n + i]);
                    *(u32x4*)(HID + (size_t)R * 256 + n) = pack8(v); } }
    }
};
struct EpiCmp2 { unsigned char* ws; int kv;
    DEV void operator()(const pg::Acc& acc, const pg::Unit& u, int wr, int wc, int fr, int fq) const {
        if (wc >= 2) return;
        const float* rc = (const float*)(ws + OFF_ROPEC); const float* rsn = (const float*)(ws + OFF_ROPES);
        bf16_t* OUT = (bf16_t*)(ws + (kv ? OFF_VC : OFF_KC));
#pragma unroll
        for (int ai = 0; ai < 2; ++ai)
#pragma unroll
            for (int m = 0; m < 4; ++m) { const int R = u.pm * 256 + ai * 128 + wr * 64 + m * 16 + fr, cidx = R & 127;
                const int n = wc * 32 + 8 * fq; float v[8]; PACC8(v, acc, ai, 0, m);
                if (kv == 0 && n < 16) { const int pos = (cidx < 127 ? cidx : 126) * 16 + 31, p0 = n >> 1;
                    const f32x4 cs = *(const f32x4*)(rc + pos * 8 + p0), sn = *(const f32x4*)(rsn + pos * 8 + p0);
#pragma unroll
                    for (int pr = 0; pr < 4; ++pr) { const float x1 = v[2 * pr], x2 = v[2 * pr + 1]; v[2 * pr] = x1 * cs[pr] - x2 * sn[pr]; v[2 * pr + 1] = x2 * cs[pr] + x1 * sn[pr]; } }
                if (cidx == 127) {
#pragma unroll
                    for (int i = 0; i < 8; ++i) v[i] = 0.f; }
                *(u32x4*)(OUT + (size_t)R * 64 + n) = pack8(v); }
    }
};

struct EpiOut { unsigned char* ws; const float* x;
    DEV void operator()(const pg::Acc& acc, const pg::Unit& u, int wr, int wc, int fr, int fq) const {
        bf16_t* XB = (bf16_t*)(ws + OFF_X1B); bf16_t* XL = (bf16_t*)(ws + OFF_X1L);
#pragma unroll
        for (int ai = 0; ai < 2; ++ai)
#pragma unroll
            for (int m = 0; m < 4; ++m) { const int tok = u.pm * 256 + ai * 128 + wr * 64 + m * 16 + fr;
#pragma unroll
                for (int bj = 0; bj < 2; ++bj) { const int n = u.pn * 256 + bj * 128 + wc * 32 + 8 * fq; float v[8], lo[8]; PACC8(v, acc, ai, bj, m);
                    const f32x4 xa = *(const f32x4*)(x + (size_t)tok * 1024 + n), xb = *(const f32x4*)(x + (size_t)tok * 1024 + n + 4);
#pragma unroll
                    for (int i = 0; i < 4; ++i) { v[i] += xa[i]; v[4 + i] += xb[i]; }
                    const u32x4 h = pack8(v);
                    lo[0] = v[0] - bf_lo(h.x); lo[1] = v[1] - bf_hi(h.x); lo[2] = v[2] - bf_lo(h.y); lo[3] = v[3] - bf_hi(h.y);
                    lo[4] = v[4] - bf_lo(h.z); lo[5] = v[5] - bf_hi(h.z); lo[6] = v[6] - bf_lo(h.w); lo[7] = v[7] - bf_hi(h.w);
                    *(u32x4*)(XB + (size_t)tok * 1024 + n) = h; *(u32x4*)(XL + (size_t)tok * 1024 + n) = pack8(lo); } }
    }
};

struct EpiMoe1 { unsigned char* ws;
    DEV void operator()(const pg::Acc& acc, const pg::Unit& u, int wr, int wc, int fr, int fq) const {
        const float* RS = (const float*)(ws + OFF_RSTD2); bf16_t* HE = (bf16_t*)(ws + OFF_HE); const unsigned* list = (const unsigned*)(ws + OFF_LIST) + (size_t)u.x0 * 65536;
#pragma unroll
        for (int ai = 0; ai < 2; ++ai)
#pragma unroll
            for (int m = 0; m < 4; ++m) { const int lr = ai * 128 + wr * 64 + m * 16 + fr, pos = u.x1 + lr; const int tok = pos < u.x2 ? (int)(list[pos] >> 1) : 0; const float r = RS[tok];
                const int j = u.pn * 128 + wc * 32 + 8 * fq; float g[8], up[8], v[8]; PACC8(g, acc, ai, 0, m); PACC8(up, acc, ai, 1, m);
#pragma unroll
                for (int i = 0; i < 8; ++i) { const float a = g[i] * r; v[i] = a / (1.f + __expf(-a)) * (up[i] * r); }
                *(u32x4*)(HE + (size_t)(u.pm * 256 + lr) * 256 + j) = pack8(v); }
    }
};
struct EpiMoe2 { unsigned char* ws;
    DEV void operator()(const pg::Acc& acc, const pg::Unit& u, int wr, int wc, int fr, int fq) const {
        bf16_t* Y = (bf16_t*)(ws + OFF_Y);
#pragma unroll
        for (int ai = 0; ai < 2; ++ai)
#pragma unroll
            for (int m = 0; m < 4; ++m) { const int lr = ai * 128 + wr * 64 + m * 16 + fr;
#pragma unroll
                for (int bj = 0; bj < 2; ++bj) { const int n = u.pn * 256 + bj * 128 + wc * 32 + 8 * fq; float v[8]; PACC8(v, acc, ai, bj, m);
                    __builtin_nontemporal_store(pack8(v), (u32x4*)(Y + (size_t)(u.pm * 256 + lr) * 1024 + n)); } }
    }
};

struct Flash { f32x16 o0, o1; float m, l; };
DEV void flash_init(Flash& s) {
#pragma unroll
    for (int i = 0; i < 16; ++i) { s.o0[i] = 0.f; s.o1[i] = 0.f; }
    s.m = -INFINITY; s.l = 0.f; }
DEV s16x4 tr_read(LDSP p) { return __builtin_bit_cast(s16x4, __builtin_amdgcn_ds_read_tr16_b64_v4i16((LDS s16x4*)p)); }

DEV void flash_stage(const u32x4 (&kch)[4], const u32x4 (&vch)[4], LDSP vl, int lane) {
    const int c = lane & 7, row = lane >> 3; const int wo = (c >> 2) * 2048 + row * 64 + (c & 3) * 16;
#pragma unroll
    for (int i = 0; i < 4; ++i) { const int r = row + 8 * i; *(LDS u32x4*)(vl + 4096 + r * 128 + ((c ^ ((r >> 1) & 7)) << 4)) = kch[i]; *(LDS u32x4*)(vl + wo + i * 512) = vch[i]; }
}
DEV void flash_tile(Flash& st, const bf16x8 (&qf)[4], LDSP vl, int rl, int rh, int lane) {
    const int hl = lane >> 5, l31 = lane & 31;
    asm volatile("s_waitcnt lgkmcnt(0)" ::: "memory");
    f32x16 s;
#pragma unroll
    for (int i = 0; i < 16; ++i) s[i] = 0.f;
#pragma unroll
    for (int ks = 0; ks < 4; ++ks) { const bf16x8 kf = *(const LDS bf16x8*)(vl + 4096 + l31 * 128 + (((2 * ks + hl) ^ ((l31 >> 1) & 7)) << 4)); s = MFMA32(kf, qf[ks], s); }
    float mx = -INFINITY;
    const bool lfull = (rl <= 0) && (rh >= 27), lnone = (rh < 0) || (rl > 27) || (rh < rl);
    bool lane_off = false;
    const bool interior = __all(lfull || lnone);
    if (__builtin_expect(interior, 1)) {
#pragma unroll
        for (int i = 0; i < 16; ++i) mx = fmaxf(mx, s[i]);
        lane_off = !lfull; mx = lane_off ? -INFINITY : mx;
    } else {
#pragma unroll
        for (int i = 0; i < 16; ++i) { const int ci = (i & 3) + 8 * (i >> 2); const bool ok = (ci >= rl) && (ci <= rh); mx = fmaxf(mx, ok ? s[i] : -INFINITY); }
    }
    mx = xhalf_max(mx);
    float rs = 0.f;
    const bool grow = mx > st.m + 8.0f;
    const bool moved = __any(grow);
    const float mnew = grow ? mx : st.m, ms = (mnew == -INFINITY) ? 0.f : mnew;
    const float alpha = fexp2(st.m - ms);
    const float msub = lane_off ? INFINITY : ms;
    float pe[16];
#pragma unroll
    for (int i = 0; i < 16; ++i) pe[i] = fexp2(s[i] - msub);
    if (__builtin_expect(!interior, 0)) {
#pragma unroll
        for (int i = 0; i < 16; ++i) { const int ci = (i & 3) + 8 * (i >> 2); const bool ok = (ci >= rl) && (ci <= rh); pe[i] = ok ? pe[i] : 0.f; }
    }
#pragma unroll
    for (int i = 0; i < 16; ++i) rs += pe[i];
    st.l = st.l * alpha + rs; st.m = mnew;
    if (__builtin_expect(moved, 0)) {
#pragma unroll
        for (int i = 0; i < 16; ++i) { st.o0[i] *= alpha; st.o1[i] *= alpha; }
    }
    unsigned pk[8];
#pragma unroll
    for (int j = 0; j < 8; ++j) pk[j] = cvt_pk(pe[2 * j], pe[2 * j + 1]);
    asm volatile("s_waitcnt lgkmcnt(0)" ::: "memory");
    const int rb = (hl * 4 + ((lane & 15) >> 2)) * 64 + ((lane >> 4) & 1) * 32 + (lane & 3) * 8;
#pragma unroll
    for (int s2 = 0; s2 < 2; ++s2) {
        u32x4 pw; pw.x = pk[4 * s2]; pw.y = pk[4 * s2 + 1]; pw.z = pk[4 * s2 + 2]; pw.w = pk[4 * s2 + 3];
        const bf16x8 pf = __builtin_bit_cast(bf16x8, pw);
        { const s16x4 v0 = tr_read(vl + (16 * s2) * 64 + rb), v1 = tr_read(vl + (16 * s2 + 8) * 64 + rb);
          const bf16x8 vf = __builtin_shufflevector(v0, v1, 0, 1, 2, 3, 4, 5, 6, 7); st.o0 = MFMA32(vf, pf, st.o0); }
        { const s16x4 v0 = tr_read(vl + 2048 + (16 * s2) * 64 + rb), v1 = tr_read(vl + 2048 + (16 * s2 + 8) * 64 + rb);
          const bf16x8 vf = __builtin_shufflevector(v0, v1, 0, 1, 2, 3, 4, 5, 6, 7); st.o1 = MFMA32(vf, pf, st.o1); }
    }
    asm volatile("s_waitcnt lgkmcnt(0)" ::: "memory");
}
DEV bool tile_need(int kt, int lo, int hi, unsigned selmask) { const int kb = kt * 32; const int hie = ((selmask >> (kt >> 1)) & 1u) ? hi : -1; return (hie >= kb) && (lo <= kb + 31) && (hie >= lo); }
#define FR_NEXT(k) do { ++(k); while ((k) < kt1 && !__any(tile_need((k), lo, hi, selmask))) ++(k); } while (0)
#define FR_LOAD(KR, VR, k) do { _Pragma("unroll") for (int i_ = 0; i_ < 4; ++i_) { KR[i_] = *(const u32x4*)(kp + (size_t)((k) * 32 + 8 * i_) * stride); VR[i_] = *(const u32x4*)(vp + (size_t)((k) * 32 + 8 * i_) * stride); } } while (0)
DEV void flash_range(Flash& st, const bf16x8 (&qf)[4], const bf16_t* kbase, const bf16_t* vbase, int stride, int kt0, int kt1, int lo, int hi, unsigned selmask, LDSP vl, int lane) {
    const int hl = lane >> 5;
    const bf16_t* kp = kbase + (size_t)(lane >> 3) * stride + (lane & 7) * 8;
    const bf16_t* vp = vbase + (size_t)(lane >> 3) * stride + (lane & 7) * 8;
    int ta = kt0 - 1; FR_NEXT(ta);
    if (ta >= kt1) return;
    u32x4 kA[4], vA[4], kB[4], vB[4];
    FR_LOAD(kA, vA, ta);
    int tb = ta; FR_NEXT(tb);
    if (tb < kt1) FR_LOAD(kB, vB, tb);
    int cur = 0;
    flash_stage(kA, vA, vl, lane);
    int tc = tb; if (tb < kt1) { FR_NEXT(tc); if (tc < kt1) FR_LOAD(kA, vA, tc); }
    for (;;) {
        { const int kb = ta * 32; const int hie = ((selmask >> (ta >> 1)) & 1u) ? hi : -1; flash_tile(st, qf, vl + cur, lo - kb - 4 * hl, hie - kb - 4 * hl, lane); }
        if (tb >= kt1) break;
        cur ^= 8192; flash_stage(kB, vB, vl + cur, lane);
        ta = tb; tb = tc; if (tc < kt1) { FR_NEXT(tc); if (tc < kt1) FR_LOAD(kB, vB, tc); }
        { const int kb = ta * 32; const int hie = ((selmask >> (ta >> 1)) & 1u) ? hi : -1; flash_tile(st, qf, vl + cur, lo - kb - 4 * hl, hie - kb - 4 * hl, lane); }
        if (tb >= kt1) break;
        cur ^= 8192; flash_stage(kA, vA, vl + cur, lane);
        ta = tb; tb = tc; if (tc < kt1) { FR_NEXT(tc); if (tc < kt1) FR_LOAD(kA, vA, tc); }
    }
}
#undef FR_NEXT
#undef FR_LOAD
DEV float flash_final(Flash& st) { const float lt = xhalf_sum(st.l); const float inv = lt > 0.f ? 1.f / lt : 0.f;
#pragma unroll
    for (int i = 0; i < 16; ++i) { st.o0[i] *= inv; st.o1[i] *= inv; }
    return lt; }
DEV void store_o(bf16_t* dst  , const f32x16& o0, const f32x16& o1, int hl) {
#pragma unroll
    for (int g = 0; g < 4; ++g) { u32x2 w; w.x = cvt_pk(o0[4 * g], o0[4 * g + 1]); w.y = cvt_pk(o0[4 * g + 2], o0[4 * g + 3]); *(u32x2*)(dst + 8 * g + 4 * hl) = w;
        u32x2 z; z.x = cvt_pk(o1[4 * g], o1[4 * g + 1]); z.y = cvt_pk(o1[4 * g + 2], o1[4 * g + 3]); *(u32x2*)(dst + 32 + 8 * g + 4 * hl) = z; }
}
DEV unsigned wave_pull(unsigned* ctr, int lane) { unsigned v = 0; if (lane == 0) v = __hip_atomic_fetch_add(ctr, 1u, __ATOMIC_RELAXED, __HIP_MEMORY_SCOPE_AGENT); return (unsigned)__builtin_amdgcn_readfirstlane((int)v); }

DEV void dilated_task(const Params& p, int id, LDSP vl, int lane) {
    unsigned char* ws = p.ws; const int l31 = lane & 31, hl = lane >> 5;
    const int j = id & 63, pat = (id >> 6) % 3, bh = id / 192;
    int dil, r, qb;
    if (pat == 0) { dil = 1; r = 0; qb = j; } else if (pat == 1) { dil = 4; r = j >> 4; qb = j & 15; } else { dil = 16; r = j >> 2; qb = j & 3; }
    const bf16_t* Q = (const bf16_t*)(ws + OFF_QA) + (size_t)bh * 2048 * 64 + r * 64;
    const bf16_t* K = (const bf16_t*)(ws + OFF_KA) + (size_t)bh * 2048 * 64 + r * 64;
    const bf16_t* V = (const bf16_t*)(ws + OFF_VA) + (size_t)bh * 2048 * 64 + r * 64;
    const int stride = dil * 64, mq = qb * 32 + l31;
    bf16x8 qf[4];
#pragma unroll
    for (int ks = 0; ks < 4; ++ks) qf[ks] = *(const bf16x8*)(Q + (size_t)mq * stride + ks * 16 + hl * 8);
    Flash st; flash_init(st);
    flash_range(st, qf, K, V, stride, qb >= 4 ? qb - 4 : 0, qb + 1, mq >= 128 ? mq - 128 : 0, mq, 0xffffffffu, vl, lane);
    const float lt = flash_final(st);
    const int b = bh >> 3, h = bh & 7, tok = b * 2048 + mq * dil + r;
    store_o((bf16_t*)(ws + OFF_OP) + ((size_t)pat * T_TOK + tok) * 512 + h * 64, st.o0, st.o1, hl);
    if (hl == 0) __hip_atomic_store((float*)(ws + OFF_LSE) + ((size_t)pat * T_TOK + tok) * 8 + h, st.m + __builtin_log2f(lt), __ATOMIC_RELAXED, __HIP_MEMORY_SCOPE_AGENT);
}

DEV void dilated_pair(const Params& p, int id, LDSP vl, int lane) {
    unsigned char* ws = p.ws; const int l31 = lane & 31, hl = lane >> 5;
    const int j = id & 31, pat = (id >> 5) % 3, bh = id / 96;
    int dil, r, qb;
    if (pat == 0) { dil = 1; r = 0; qb = 2 * j; } else if (pat == 1) { dil = 4; r = j >> 3; qb = 2 * (j & 7); } else { dil = 16; r = j >> 1; qb = 2 * (j & 1); }
    const bf16_t* Q = (const bf16_t*)(ws + OFF_QA) + (size_t)bh * 2048 * 64 + r * 64;
    const bf16_t* K = (const bf16_t*)(ws + OFF_KA) + (size_t)bh * 2048 * 64 + r * 64;
    const bf16_t* V = (const bf16_t*)(ws + OFF_VA) + (size_t)bh * 2048 * 64 + r * 64;
    const int stride = dil * 64, mqA = qb * 32 + l31, mqB = mqA + 32;
    bf16x8 qfA[4], qfB[4];
#pragma unroll
    for (int ks = 0; ks < 4; ++ks) { qfA[ks] = *(const bf16x8*)(Q + (size_t)mqA * stride + ks * 16 + hl * 8); qfB[ks] = *(const bf16x8*)(Q + (size_t)mqB * stride + ks * 16 + hl * 8); }
    Flash sA, sB; flash_init(sA); flash_init(sB);
    const int loA = mqA >= 128 ? mqA - 128 : 0, loB = mqB >= 128 ? mqB - 128 : 0;
    const int kt1 = qb + 2;
    int ta = qb >= 4 ? qb - 4 : 0;
    const bf16_t* kp = K + (size_t)(lane >> 3) * stride + (lane & 7) * 8;
    const bf16_t* vp = V + (size_t)(lane >> 3) * stride + (lane & 7) * 8;
#define DP_LOAD(KR, VR, k) do { _Pragma("unroll") for (int i_ = 0; i_ < 4; ++i_) { KR[i_] = *(const u32x4*)(kp + (size_t)((k) * 32 + 8 * i_) * stride); VR[i_] = *(const u32x4*)(vp + (size_t)((k) * 32 + 8 * i_) * stride); } } while (0)
#define DP_TILE(kt, buf) do { const int kb_ = (kt) * 32; \
        if ((kt) <= qb) flash_tile(sA, qfA, (buf), loA - kb_ - 4 * hl, mqA - kb_ - 4 * hl, lane); \
        if ((kt) >= qb - 3) flash_tile(sB, qfB, (buf), loB - kb_ - 4 * hl, mqB - kb_ - 4 * hl, lane); } while (0)
    u32x4 kA[4], vA[4], kB[4], vB[4];
    DP_LOAD(kA, vA, ta);
    DP_LOAD(kB, vB, ta + 1);
    int cur = 0;
    flash_stage(kA, vA, vl, lane);
    if (ta + 2 < kt1) DP_LOAD(kA, vA, ta + 2);
    for (;;) {
        DP_TILE(ta, vl + cur);
        if (ta + 1 >= kt1) break;
        cur ^= 8192; flash_stage(kB, vB, vl + cur, lane);
        ++ta; if (ta + 2 < kt1) DP_LOAD(kB, vB, ta + 2);
        DP_TILE(ta, vl + cur);
        if (ta + 1 >= kt1) break;
        cur ^= 8192; flash_stage(kA, vA, vl + cur, lane);
        ++ta; if (ta + 2 < kt1) DP_LOAD(kA, vA, ta + 2);
    }
#undef DP_LOAD
#undef DP_TILE
    const int b = bh >> 3, h = bh & 7;
    { const float lt = flash_final(sA); const int tok = b * 2048 + mqA * dil + r;
      store_o((bf16_t*)(ws + OFF_OP) + ((size_t)pat * T_TOK + tok) * 512 + h * 64, sA.o0, sA.o1, hl);
      if (hl == 0) __hip_atomic_store((float*)(ws + OFF_LSE) + ((size_t)pat * T_TOK + tok) * 8 + h, sA.m + __builtin_log2f(lt), __ATOMIC_RELAXED, __HIP_MEMORY_SCOPE_AGENT); }
    { const float lt = flash_final(sB); const int tok = b * 2048 + mqB * dil + r;
      store_o((bf16_t*)(ws + OFF_OP) + ((size_t)pat * T_TOK + tok) * 512 + h * 64, sB.o0, sB.o1, hl);
      if (hl == 0) __hip_atomic_store((float*)(ws + OFF_LSE) + ((size_t)pat * T_TOK + tok) * 8 + h, sB.m + __builtin_log2f(lt), __ATOMIC_RELAXED, __HIP_MEMORY_SCOPE_AGENT); }
}

DEV void merge_tokens(const Params& p, int lane, int wid) {
    unsigned char* ws = p.ws; const bf16_t* OP = (const bf16_t*)(ws + OFF_OP); const float* LSE = (const float*)(ws + OFF_LSE); bf16_t* MIX = (bf16_t*)(ws + OFF_R1);
    const int h = lane >> 3, d0 = (lane & 7) * 8;
    for (int tok = blockIdx.x * 8 + wid; tok < T_TOK; tok += 2048) {
        float l0 = LSE[(size_t)tok * 8 + h], l1 = LSE[((size_t)T_TOK + tok) * 8 + h], l2 = LSE[((size_t)2 * T_TOK + tok) * 8 + h];
        const float mx = fmaxf(l0, fmaxf(l1, l2)); l0 = fexp2(l0 - mx); l1 = fexp2(l1 - mx); l2 = fexp2(l2 - mx); const float inv = 1.f / (l0 + l1 + l2); l0 *= inv; l1 *= inv; l2 *= inv;
        const u32x4 a = *(const u32x4*)(OP + (size_t)tok * 512 + h * 64 + d0), b = *(const u32x4*)(OP + ((size_t)T_TOK + tok) * 512 + h * 64 + d0), c = *(const u32x4*)(OP + ((size_t)2 * T_TOK + tok) * 512 + h * 64 + d0);
        u32x4 w;
#pragma unroll
        for (int i = 0; i < 4; ++i) { const float lo = l0 * bf_lo(a[i]) + l1 * bf_lo(b[i]) + l2 * bf_lo(c[i]), hi = l0 * bf_hi(a[i]) + l1 * bf_hi(b[i]) + l2 * bf_hi(c[i]); w[i] = cvt_pk(lo, hi); }
        *(u32x4*)(MIX + (size_t)tok * 1024 + h * 64 + d0) = w;
    }
}

DEV void nsa_sel_task(const Params& p, int qb, int bg, int lane) {
    unsigned char* ws = p.ws; const int l31 = lane & 31, hl = lane >> 5;
    const int b = bg >> 1, g = bg & 1, t0 = qb * 32, t = t0 + l31, tok = b * 2048 + t;
    const bf16_t* KC = (const bf16_t*)(ws + OFF_KC) + (size_t)bg * 128 * 64; const bf16_t* VC = (const bf16_t*)(ws + OFF_VC) + (size_t)bg * 128 * 64;
    const bf16_t* KS = (const bf16_t*)(ws + OFF_KV6 + 2 * 16 * MB) + (size_t)bg * 2048 * 64; const bf16_t* VS = (const bf16_t*)(ws + OFF_KV6 + 3 * 16 * MB) + (size_t)bg * 2048 * 64;
    const bf16_t* KW = (const bf16_t*)(ws + OFF_KV6 + 4 * 16 * MB) + (size_t)bg * 2048 * 64; const bf16_t* VW = (const bf16_t*)(ws + OFF_KV6 + 5 * 16 * MB) + (size_t)bg * 2048 * 64;
    const bf16_t* QBp = (const bf16_t*)(ws + OFF_QB) + ((size_t)(b * 8 + g * 4) * 2048 + t) * 64 + hl * 8;
    const int cmax = (t >= 31) ? (((t - 31) >> 4) < 126 ? ((t - 31) >> 4) : 126) : -1;
    f32x16 ps[4];
#pragma unroll
    for (int ct = 0; ct < 4; ++ct)
#pragma unroll
        for (int i = 0; i < 16; ++i) ps[ct][i] = 0.f;
#pragma unroll 1
    for (int r = 0; r < 4; ++r) {
        bf16x8 qf[4];
#pragma unroll
        for (int ks = 0; ks < 4; ++ks) qf[ks] = *(const bf16x8*)(QBp + (size_t)r * 2048 * 64 + ks * 16);
        float mx = -INFINITY, sum = 0.f;
#pragma unroll 1
        for (int ct = 0; ct < 4; ++ct) {
            f32x16 sc;
#pragma unroll
            for (int i = 0; i < 16; ++i) sc[i] = 0.f;
#pragma unroll
            for (int ks = 0; ks < 4; ++ks) { const bf16x8 kf = *(const bf16x8*)(KC + (size_t)(ct * 32 + l31) * 64 + ks * 16 + hl * 8); sc = MFMA32(kf, qf[ks], sc); }
            float tm = -INFINITY;
#pragma unroll
            for (int i = 0; i < 16; ++i) { const int c = ct * 32 + (i & 3) + 8 * (i >> 2) + 4 * hl; sc[i] = (c <= cmax) ? sc[i] : -INFINITY; tm = fmaxf(tm, sc[i]); }
            const float mn = fmaxf(mx, tm), ms = (mn == -INFINITY) ? 0.f : mn;
            float rs = 0.f;
#pragma unroll
            for (int i = 0; i < 16; ++i) rs += fexp2(sc[i] - ms);
            sum = sum * fexp2(mx - ms) + rs; mx = mn;
        }
        { const float mo = __shfl_xor(mx, 32), so = __shfl_xor(sum, 32); const float mn = fmaxf(mx, mo), ms = (mn == -INFINITY) ? 0.f : mn;
          sum = sum * fexp2(mx - ms) + so * fexp2(mo - ms); mx = ms; }
        const float inv = sum > 0.f ? 1.f / sum : 0.f;
#pragma unroll
        for (int ct = 0; ct < 4; ++ct) {
            f32x16 sc;
#pragma unroll
            for (int i = 0; i < 16; ++i) sc[i] = 0.f;
#pragma unroll
            for (int ks = 0; ks < 4; ++ks) { const bf16x8 kf = *(const bf16x8*)(KC + (size_t)(ct * 32 + l31) * 64 + ks * 16 + hl * 8); sc = MFMA32(kf, qf[ks], sc); }
#pragma unroll
            for (int i = 0; i < 16; ++i) { const int c = ct * 32 + (i & 3) + 8 * (i >> 2) + 4 * hl; const float e = (c <= cmax) ? fexp2(sc[i] - mx) * inv : 0.f; ps[ct][i] += e; }
        }
    }
    float ie[16], io[16];
    {
        float A[16], Tp[16];
#pragma unroll
        for (int ct = 0; ct < 4; ++ct)
#pragma unroll
            for (int gq = 0; gq < 4; ++gq) { const int jj = ct * 4 + gq; const float p3 = 0.5f * ps[ct][4 * gq + 3]; A[jj] = ps[ct][4 * gq] + ps[ct][4 * gq + 1] + ps[ct][4 * gq + 2] + p3; Tp[jj] = __shfl_xor(p3, 32); }
#pragma unroll
        for (int jj = 0; jj < 16; ++jj) { const float prev = (jj > 0) ? Tp[jj > 0 ? jj - 1 : 0] : 0.f; const float own = A[jj] + (hl ? Tp[jj] : prev); const float oth = __shfl_xor(own, 32);
            ie[jj] = hl ? oth : own; io[jj] = hl ? own : oth; }
    }
    const int blk = t0 >> 6;
    unsigned sel = 1u | (1u << blk) | (blk > 0 ? (1u << (blk - 1)) : 0u);
    {
        const int nforced = blk >= 2 ? 3 : blk + 1, nsel = 8 - nforced, ncand = blk - 2;
        if (ncand > 0) {
            if (ncand <= nsel) sel |= ((1u << (blk - 1)) - 2u);
            else {
#pragma unroll
                for (int jj = 0; jj < 16; ++jj) { const int je = 2 * jj, jo = 2 * jj + 1; ie[jj] = (je >= 1 && je <= blk - 2) ? ie[jj] : -1.f; io[jj] = (jo >= 1 && jo <= blk - 2) ? io[jj] : -1.f; }
                unsigned bits = 0u;
#pragma unroll
                for (int jj = 0; jj < 16; ++jj) {
                    const float cj = hl ? io[jj] : ie[jj]; int cnt = 0;
#pragma unroll
                    for (int j2 = 0; j2 < 16; ++j2) {
                        const bool lte = (j2 < jj) || (j2 == jj && hl);
                        const bool lto = (j2 < jj);
                        cnt += ((ie[j2] > cj) || (ie[j2] == cj && lte)) ? 1 : 0;
                        cnt += ((io[j2] > cj) || (io[j2] == cj && lto)) ? 1 : 0;
                    }
                    if (cj >= 0.f && cnt < nsel) bits |= (1u << (2 * jj)) << hl;
                }
                bits |= (unsigned)__shfl_xor((int)bits, 32);
                sel |= bits;
            }
        }
    }
    if (hl == 0) ((unsigned*)(ws + OFF_SEL))[(size_t)bg * 2048 + t] = sel;
}

DEV void nsa_head_task(const Params& p, int qb, int bg, int r, LDSP vl, int lane) {
    unsigned char* ws = p.ws; const int l31 = lane & 31, hl = lane >> 5;
    const int b = bg >> 1, g = bg & 1, t0 = qb * 32, t = t0 + l31, tok = b * 2048 + t;
    const bf16_t* KC = (const bf16_t*)(ws + OFF_KC) + (size_t)bg * 128 * 64; const bf16_t* VC = (const bf16_t*)(ws + OFF_VC) + (size_t)bg * 128 * 64;
    const bf16_t* KS = (const bf16_t*)(ws + OFF_KV6 + 2 * 16 * MB) + (size_t)bg * 2048 * 64; const bf16_t* VS = (const bf16_t*)(ws + OFF_KV6 + 3 * 16 * MB) + (size_t)bg * 2048 * 64;
    const bf16_t* KW = (const bf16_t*)(ws + OFF_KV6 + 4 * 16 * MB) + (size_t)bg * 2048 * 64; const bf16_t* VW = (const bf16_t*)(ws + OFF_KV6 + 5 * 16 * MB) + (size_t)bg * 2048 * 64;
    const bf16_t* QBp = (const bf16_t*)(ws + OFF_QB) + ((size_t)(b * 8 + g * 4 + r) * 2048 + t) * 64 + hl * 8;
    const int cmax = (t >= 31) ? (((t - 31) >> 4) < 126 ? ((t - 31) >> 4) : 126) : -1;
    const unsigned sel = ((const unsigned*)(ws + OFF_SEL))[(size_t)bg * 2048 + t];
    const float* GT = (const float*)(ws + OFF_GATE) + (size_t)tok * 24 + (g * 4 + r) * 3;
    bf16_t* MIX = (bf16_t*)(ws + OFF_R1) + (size_t)tok * 1024 + 512 + (g * 4 + r) * 64;
    const int wlo = t >= 511 ? t - 511 : 0, wk0 = (t0 >> 5) >= 16 ? (t0 >> 5) - 16 : 0, kend = (t0 >> 5) + 1;
    bf16x8 qf[4];
#pragma unroll
    for (int ks = 0; ks < 4; ++ks) qf[ks] = *(const bf16x8*)(QBp + ks * 16);
    const float g0 = GT[0], g1 = GT[1], g2 = GT[2];
    f32x16 t0a, t1a;
    { Flash st; flash_init(st); flash_range(st, qf, KC, VC, 64, 0, 4, 0, cmax, 0xffffffffu, vl, lane); flash_final(st);
#pragma unroll
      for (int i = 0; i < 16; ++i) { t0a[i] = g0 * st.o0[i]; t1a[i] = g0 * st.o1[i]; } }
    { Flash st; flash_init(st); flash_range(st, qf, KS, VS, 64, 0, kend, 0, t, sel, vl, lane); flash_final(st);
#pragma unroll
      for (int i = 0; i < 16; ++i) { t0a[i] += g1 * st.o0[i]; t1a[i] += g1 * st.o1[i]; } }
    { Flash st; flash_init(st); flash_range(st, qf, KW, VW, 64, wk0, kend, wlo, t, 0xffffffffu, vl, lane); flash_final(st);
#pragma unroll
      for (int i = 0; i < 16; ++i) { t0a[i] += g2 * st.o0[i]; t1a[i] += g2 * st.o1[i]; } }
    store_o(MIX, t0a, t1a, hl);
}

DEV void wg_sync() { asm volatile("s_waitcnt lgkmcnt(0)" ::: "memory"); __builtin_amdgcn_s_barrier(); asm volatile("" ::: "memory"); }
DEV void coop_branch(Flash& st, const bf16x8 (&qf)[4], const bf16_t* kbase, const bf16_t* vbase, int j0, int j1, unsigned blockmask, int lo, int hi, unsigned selmask, LDSP sb, int tid, int lane) {
    const int hl = lane >> 5;
    const int sh = tid >> 8, lt = tid & 255, row = lt >> 3, c = lt & 7;
    const bf16_t* src = (sh ? vbase : kbase) + (size_t)row * 64 + c * 8;
    const int dsto = sh ? ((c >> 2) * 2048 + row * 64 + (c & 3) * 16) : (4096 + row * 128 + ((c ^ ((row >> 1) & 7)) << 4));
#define CB_NEXT(k) do { ++(k); while ((k) < j1 && !((blockmask >> (k)) & 1u)) ++(k); } while (0)
    int ja = j0 - 1; CB_NEXT(ja);
    if (ja >= j1) return;
    u32x4 r0 = *(const u32x4*)(src + (size_t)ja * 64 * 64), r1 = *(const u32x4*)(src + (size_t)(ja * 64 + 32) * 64);
    int jb = ja; CB_NEXT(jb);
    *(LDS u32x4*)(sb + dsto) = r0; *(LDS u32x4*)(sb + 8192 + dsto) = r1;
    if (jb < j1) { r0 = *(const u32x4*)(src + (size_t)jb * 64 * 64); r1 = *(const u32x4*)(src + (size_t)(jb * 64 + 32) * 64); }
    wg_sync();
    int cur = 0;
    for (;;) {
        const int hie = ((selmask >> ja) & 1u) ? hi : -1;
#pragma unroll
        for (int h2 = 0; h2 < 2; ++h2) { const int kb = ja * 64 + h2 * 32;
            if (__any((hie >= kb) && (lo <= kb + 31) && (hie >= lo))) flash_tile(st, qf, sb + cur + h2 * 8192, lo - kb - 4 * hl, hie - kb - 4 * hl, lane); }
        if (jb >= j1) break;
        *(LDS u32x4*)(sb + (cur ^ 16384) + dsto) = r0; *(LDS u32x4*)(sb + (cur ^ 16384) + 8192 + dsto) = r1;
        int jc = jb; CB_NEXT(jc);
        if (jc < j1) { r0 = *(const u32x4*)(src + (size_t)jc * 64 * 64); r1 = *(const u32x4*)(src + (size_t)(jc * 64 + 32) * 64); }
        wg_sync();
        cur ^= 16384; ja = jb; jb = jc;
    }
    wg_sync();
#undef CB_NEXT
}
DEV void nsa_wg_task(const Params& p, int qq, int bg, LDSP lds, int tid, int lane, int wid) {
    unsigned char* ws = p.ws; const int l31 = lane & 31, hl = lane >> 5, r = wid & 3, half = wid >> 2;
    const int b = bg >> 1, g = bg & 1, t0 = qq * 64 + 32 * half, t = t0 + l31, tok = b * 2048 + t;
    const bf16_t* KC = (const bf16_t*)(ws + OFF_KC) + (size_t)bg * 128 * 64; const bf16_t* VC = (const bf16_t*)(ws + OFF_VC) + (size_t)bg * 128 * 64;
    const bf16_t* KS = (const bf16_t*)(ws + OFF_KV6 + 2 * 16 * MB) + (size_t)bg * 2048 * 64; const bf16_t* VS = (const bf16_t*)(ws + OFF_KV6 + 3 * 16 * MB) + (size_t)bg * 2048 * 64;
    const bf16_t* KW = (const bf16_t*)(ws + OFF_KV6 + 4 * 16 * MB) + (size_t)bg * 2048 * 64; const bf16_t* VW = (const bf16_t*)(ws + OFF_KV6 + 5 * 16 * MB) + (size_t)bg * 2048 * 64;
    const bf16_t* QBp = (const bf16_t*)(ws + OFF_QB) + ((size_t)(b * 8 + g * 4 + r) * 2048 + t) * 64 + hl * 8;
    const int cmax = (t >= 31) ? (((t - 31) >> 4) < 126 ? ((t - 31) >> 4) : 126) : -1;
    const unsigned sel = ((const unsigned*)(ws + OFF_SEL))[(size_t)bg * 2048 + t];
    unsigned um = 0u;
#pragma unroll
    for (int j = 0; j < 32; ++j) um |= __any((sel >> j) & 1u) ? (1u << j) : 0u;
    LDS unsigned* xw = (LDS unsigned*)(lds + 32768);
    if (lane == 0) xw[wid] = um;
    wg_sync();
    um = xw[0] | xw[4];
    const float* GT = (const float*)(ws + OFF_GATE) + (size_t)tok * 24 + (g * 4 + r) * 3;
    bf16_t* MIX = (bf16_t*)(ws + OFF_R1) + (size_t)tok * 1024 + 512 + (g * 4 + r) * 64;
    const int wlo = t >= 511 ? t - 511 : 0, jend = qq + 1, wj0 = qq >= 8 ? qq - 8 : 0;
    bf16x8 qf[4];
#pragma unroll
    for (int ks = 0; ks < 4; ++ks) qf[ks] = *(const bf16x8*)(QBp + ks * 16);
    const float g0 = GT[0], g1 = GT[1], g2 = GT[2];
    f32x16 t0a, t1a;
    { Flash st; flash_init(st); coop_branch(st, qf, KC, VC, 0, 2, 0xffffffffu, 0, cmax, 0xffffffffu, lds, tid, lane); flash_final(st);
#pragma unroll
      for (int i = 0; i < 16; ++i) { t0a[i] = g0 * st.o0[i]; t1a[i] = g0 * st.o1[i]; } }
    { Flash st; flash_init(st); coop_branch(st, qf, KS, VS, 0, jend, um, 0, t, sel, lds, tid, lane); flash_final(st);
#pragma unroll
      for (int i = 0; i < 16; ++i) { t0a[i] += g1 * st.o0[i]; t1a[i] += g1 * st.o1[i]; } }
    { Flash st; flash_init(st); coop_branch(st, qf, KW, VW, wj0, jend, 0xffffffffu, wlo, t, 0xffffffffu, lds, tid, lane); flash_final(st);
#pragma unroll
      for (int i = 0; i < 16; ++i) { t0a[i] += g2 * st.o0[i]; t1a[i] += g2 * st.o1[i]; } }
    store_o(MIX, t0a, t1a, hl);
}

DEV void router_wave(const Params& p, int tok0, int lane, int wid, LDSP lds) {
    unsigned char* ws = p.ws; const int l31 = lane & 31, hl = lane >> 5, tok = tok0 + l31;
    const bf16_t* xh = (const bf16_t*)(ws + OFF_X1B) + (size_t)tok * 1024 + hl * 8; const bf16_t* xl = (const bf16_t*)(ws + OFF_X1L) + (size_t)tok * 1024 + hl * 8;
    const bf16_t* WR = (const bf16_t*)(ws + OFF_WRT);
    const int r8 = lane >> 3, slot = lane & 7;
    unsigned wo[3];
#pragma unroll
    for (int i = 0; i < 3; ++i) { const int R = 24 * wid + 8 * i + r8; wo[i] = (unsigned)(R < 96 ? R : R + 32) * 1024u + (unsigned)((slot ^ ((R >> 1) & 7)) << 3); }
    const int dw = wid * 3072;
    const int fbo = l31 * 128, sw = (l31 >> 1) & 7;
    f32x16 acc[3];
#pragma unroll
    for (int a = 0; a < 3; ++a)
#pragma unroll
        for (int i = 0; i < 16; ++i) acc[a][i] = 0.f;
    float ss = 0.f;
    asm volatile("s_waitcnt lgkmcnt(0)" ::: "memory");
    __builtin_amdgcn_s_barrier();
    asm volatile("" ::: "memory");
#pragma unroll
    for (int i = 0; i < 3; ++i) GLDS16(WR + wo[i], dw + i * 1024);
    u32x4 aN[8];
#pragma unroll
    for (int ks = 0; ks < 4; ++ks) { aN[2 * ks] = *(const u32x4*)(xh + ks * 16); aN[2 * ks + 1] = *(const u32x4*)(xl + ks * 16); }
#pragma unroll 1
    for (int kt = 0; kt < 16; ++kt) {
        asm volatile("s_waitcnt vmcnt(0)" ::: "memory");
        __builtin_amdgcn_s_barrier();
        asm volatile("" ::: "memory");
        u32x4 aC[8];
#pragma unroll
        for (int i = 0; i < 8; ++i) aC[i] = aN[i];
        const int cur = (kt & 1) * 24576;
        if (kt + 1 < 16) { const int ko = (kt + 1) * 64;
#pragma unroll
            for (int ks = 0; ks < 4; ++ks) { aN[2 * ks] = *(const u32x4*)(xh + ko + ks * 16); aN[2 * ks + 1] = *(const u32x4*)(xl + ko + ks * 16); }
#pragma unroll
            for (int i = 0; i < 3; ++i) GLDS16(WR + (wo[i] + (unsigned)ko), (24576 - cur) + dw + i * 1024); }
#pragma unroll
        for (int ks = 0; ks < 4; ++ks) {
            const u32x4 ahu = aC[2 * ks], alu = aC[2 * ks + 1];
#pragma unroll
            for (int i = 0; i < 4; ++i) { const float a = bf_lo(ahu[i]) + bf_lo(alu[i]), c = bf_hi(ahu[i]) + bf_hi(alu[i]); ss += a * a + c * c; }
            const bf16x8 ah = __builtin_bit_cast(bf16x8, ahu), al = __builtin_bit_cast(bf16x8, alu);
            const int ch = ((2 * ks + hl) ^ sw) << 4;
#pragma unroll
            for (int gr = 0; gr < 3; ++gr) { const bf16x8 bh = *(const LDS bf16x8*)(lds + cur + gr * 4096 + fbo + ch), bl = *(const LDS bf16x8*)(lds + cur + 12288 + gr * 4096 + fbo + ch);
                acc[gr] = MFMA32(bh, ah, acc[gr]); acc[gr] = MFMA32(bh, al, acc[gr]); acc[gr] = MFMA32(bl, ah, acc[gr]); }
        }
    }
    ss += __shfl_xor(ss, 32);
    const float rstd = 1.0f / sqrtf(ss * (1.0f / 1024.0f) + EPSN);
    int gs = 0; float pg;
    { float lg[8], mx = -INFINITY;
#pragma unroll
      for (int i = 0; i < 8; ++i) { lg[i] = acc[0][i] * rstd + p.b_rg[i]; if (lg[i] > mx) { mx = lg[i]; gs = i; } }
      float z = 0.f;
#pragma unroll
      for (int i = 0; i < 8; ++i) z += __expf(lg[i] - mx);
      pg = 1.f / z; }
    { const int go = __shfl_xor(gs, 32); const float po = __shfl_xor(pg, 32); if (hl) { gs = go; pg = po; } }
    const int ci = gs >> 1;
    float el[8];
#pragma unroll
    for (int k = 0; k < 8; ++k) {
        const float h1 = ci == 0 ? acc[0][k] : ci == 1 ? acc[0][8 + k] : ci == 2 ? acc[1][k] : acc[1][8 + k];
        const float h0 = ci == 0 ? acc[0][8 + k] : ci == 1 ? acc[1][k] : ci == 2 ? acc[1][8 + k] : acc[2][k];
        el[k] = (hl ? h1 : h0) * rstd + p.b_re[gs * 8 + k];
    }
    if (hl == 1 - (gs & 1)) {
        int i1 = 0; float m1 = -INFINITY;
#pragma unroll
        for (int k = 0; k < 8; ++k) if (el[k] > m1) { m1 = el[k]; i1 = k; }
        int i2 = 0; float m2 = -INFINITY;
#pragma unroll
        for (int k = 0; k < 8; ++k) if (k != i1 && el[k] > m2) { m2 = el[k]; i2 = k; }
        const float e2 = __expf(m2 - m1), w1 = pg / (1.f + e2), w2 = pg * e2 / (1.f + e2);
        const int ex1 = gs * 8 + i1, ex2 = gs * 8 + i2;
        unsigned* cnt = (unsigned*)(ws + OFF_CNT); unsigned* LIST = (unsigned*)(ws + OFF_LIST);
        const unsigned p1 = __hip_atomic_fetch_add(cnt + ex1, 1u, __ATOMIC_RELAXED, __HIP_MEMORY_SCOPE_AGENT);
        const unsigned p2 = __hip_atomic_fetch_add(cnt + ex2, 1u, __ATOMIC_RELAXED, __HIP_MEMORY_SCOPE_AGENT);
        __hip_atomic_store(LIST + (size_t)ex1 * 65536 + p1, (unsigned)tok * 2u, __ATOMIC_RELAXED, __HIP_MEMORY_SCOPE_AGENT);
        __hip_atomic_store(LIST + (size_t)ex2 * 65536 + p2, (unsigned)tok * 2u + 1u, __ATOMIC_RELAXED, __HIP_MEMORY_SCOPE_AGENT);
        int* TE = (int*)(ws + OFF_TE); int* TP = (int*)(ws + OFF_TP); float* TW = (float*)(ws + OFF_TW);
        TE[tok * 2] = ex1; TE[tok * 2 + 1] = ex2; TP[tok * 2] = (int)p1; TP[tok * 2 + 1] = (int)p2; TW[tok * 2] = w1; TW[tok * 2 + 1] = w2;
        ((float*)(ws + OFF_RSTD2))[tok] = rstd;
    }
}

DEV void build_tb(const Params& p, LDS int* tb) {
    if (threadIdx.x == 0) { const unsigned* cnt = (const unsigned*)(p.ws + OFF_CNT); int a = 0;
        for (int e = 0; e < 64; ++e) { tb[e] = a; const int n = (int)((cnt[e] + 255u) >> 8); for (int t = 0; t < n; ++t) tb[128 + a + t] = e; a += n; }
        tb[64] = a; }
    __syncthreads();
}

extern __shared__ __attribute__((aligned(16))) unsigned char smem_raw[];
__global__ void __launch_bounds__(512, 2) hymba_fwd(Params p) {
    __shared__ uint4 xb_words;
    if (threadIdx.x == 0) xb_words = make_uint4(0u, 0u, 0u, 0u);
    __syncthreads();
    unsigned char* ws = p.ws;
    (void)xcd_barrier_post((unsigned*)(ws + OFF_BAR), (volatile LAS unsigned*)&xb_words);
#if DBG_XBAR
#define GRID_BAR() do { xcd_barrier((unsigned*)(p.ws + OFF_BAR), (volatile LAS unsigned*)&xb_words); xcd_barrier((unsigned*)(p.ws + OFF_BAR), (volatile LAS unsigned*)&xb_words); } while (0)
#else
#define GRID_BAR() xcd_barrier((unsigned*)(p.ws + OFF_BAR), (volatile LAS unsigned*)&xb_words)
#endif
    LDSP lds = (LDSP)smem_raw;
    const int bid = blockIdx.x, xcd = bid & 7, ci = bid >> 3;
#define PHASE_IDS const int tid = opaque((int)threadIdx.x), lane = tid & 63, wid = __builtin_amdgcn_readfirstlane(tid >> 6); LDSP vl = lds + wid * 16384; (void)lane; (void)vl;

#if SKEL < 2
    REPS(0) if (!SKEL) p0_prologue(p, lds);
    GRID_BAR();

    REPS(1) if (!SKEL) {
        const OrderXcd S{(const char*)(ws + OFF_R1), (const char*)(ws + OFF_WINT), (size_t)256 * 1024 * 2, (size_t)256 * 1024 * 2, 12, 12, xcd, ci};
        pg::gemm_phase<EpiInProj, OrderXcd, true, false>(lds, 1024, 1024, S, EpiInProj{ws});
    }
    GRID_BAR();

    REPS(20) if (!SKEL && bid < 64) {
        const int kv = bid & 1, mt = bid >> 1;
        { OrderOne S{}; S.u.a = (const char*)(ws + OFF_KV6 + (size_t)kv * 16 * MB) + (size_t)mt * 256 * 1024 * 2; S.u.b = (const char*)(ws + OFF_WC1T) + (size_t)kv * 256 * 2048 * 2; S.u.pm = mt; S.u.pn = 0; S.u.x0 = 0; S.u.x1 = 0; S.u.x2 = 0;
          pg::gemm_phase<EpiCmp1, OrderOne, false, false>(lds, 2048, 1024, S, EpiCmp1{ws, kv}); }
        asm volatile("s_waitcnt vmcnt(0)" ::: "memory");
        __syncthreads();
        { OrderOne S{}; S.u.a = (const char*)(ws + OFF_HID) + ((size_t)kv * 8192 + (size_t)mt * 256) * 256 * 2; S.u.b = (const char*)(ws + OFF_WC2T) + (size_t)kv * 256 * 256 * 2; S.u.pm = mt; S.u.pn = 0; S.u.x0 = 0; S.u.x1 = 0; S.u.x2 = 0;
          pg::gemm_phase<EpiCmp2, OrderOne, false, false>(lds, 256, 256, S, EpiCmp2{ws, kv}); }
    }
#if EN_DIL
    REPS(2) if (!SKEL) { PHASE_IDS
        unsigned* qbase = (unsigned*)(ws + OFF_QUEUE) + 512 * rep_;
        const int x0 = (int)xb_xcc_id() & 7;
        for (int dq = 0; dq < 8; ++dq) { const int x = (x0 + dq) & 7; unsigned* ctr = qbase + x * 16;
            for (;;) { const unsigned t = wave_pull(ctr, lane); if (t >= 3072u) break; dilated_pair(p, x * 3072 + (int)t, vl, opaque(lane)); } }
    }
#endif
    GRID_BAR();

    if (!SKEL) { PHASE_IDS
#if EN_DIL
    merge_tokens(p, lane, wid);
#else
    for (int tok = bid * 8 + wid; tok < T_TOK; tok += 2048) *(u32x4*)((bf16_t*)(ws + OFF_R1) + (size_t)tok * 1024 + lane * 8) = (u32x4){0u, 0u, 0u, 0u};
#endif
    }
    REPS(3) if (!SKEL) { PHASE_IDS
#if EN_NSA
        const int x0 = (int)xb_xcc_id() & 7;
        { unsigned* qbase = (unsigned*)(ws + OFF_QUEUE) + 384;
          for (int dq = 0; dq < 8; ++dq) { const int x = (x0 + dq) & 7; unsigned* ctr = qbase + x * 16;
            for (;;) { const unsigned t = wave_pull(ctr, lane); if (t >= 512u) break; nsa_sel_task(p, 63 - (int)(t & 63u), 8 * x + (int)(t >> 6), opaque(lane)); } } }
        GRID_BAR();
        { unsigned* qbase = (unsigned*)(ws + OFF_QUEUE) + 256 + 512 * rep_;
          LDS unsigned* tw = (LDS unsigned*)(lds + 32768 + 64);
          for (int dq = 0; dq < 8; ++dq) { const int x = (x0 + dq) & 7; unsigned* ctr = qbase + x * 16;
            for (;;) { if (tid == 0) tw[0] = __hip_atomic_fetch_add(ctr, 1u, __ATOMIC_RELAXED, __HIP_MEMORY_SCOPE_AGENT);
                wg_sync(); const unsigned t = tw[0]; wg_sync();
                if (t >= 256u) break;
                nsa_wg_task(p, 31 - (int)(t & 31u), 8 * x + (int)(t >> 5), lds, tid, opaque(lane), wid); } } }
#else
    for (int tok = bid * 8 + wid; tok < T_TOK; tok += 2048) *(u32x4*)((bf16_t*)(ws + OFF_R1) + (size_t)tok * 1024 + 512 + lane * 8) = (u32x4){0u, 0u, 0u, 0u};
#endif
    }
    GRID_BAR();

    REPS(4) if (!SKEL) {
        const OrderXcd S{(const char*)(ws + OFF_R1), (const char*)(ws + OFF_WOT), (size_t)256 * 1024 * 2, (size_t)256 * 1024 * 2, 4, 4, xcd, ci};
        pg::gemm_phase<EpiOut, OrderXcd, true, false>(lds, 1024, 1024, S, EpiOut{ws, p.x});
    }
    GRID_BAR();

#endif
    LDS int* tb = (LDS int*)(lds + LDS_TB); (void)tb;
#if EN_MOE && !SKEL
    { PHASE_IDS
    router_wave(p, (bid * 8 + wid) * 32, lane, wid, lds); }
    GRID_BAR();

    build_tb(p, tb);
    REPS(6) {
        const OrderMoe1 S{(const char*)(ws + OFF_X1B), (const char*)(ws + OFF_WGUT), (const unsigned*)(ws + OFF_LIST), (const unsigned*)(ws + OFF_CNT), (LDS const int*)tb, tb[64], bid};
#ifndef NO_P6
        pg::gemm_phase<EpiMoe1, OrderMoe1, true, true>(lds, 1024, 1024, S, EpiMoe1{ws});
#endif
    }
    GRID_BAR();

    REPS(7) {
        const OrderMoe2 S{(const char*)(ws + OFF_HE), (const char*)(ws + OFF_WDT), (LDS const int*)tb, tb[64], bid};
#ifndef NO_P7
        pg::gemm_phase<EpiMoe2, OrderMoe2, true, false>(lds, 256, 256, S, EpiMoe2{ws});
#endif
    }
    GRID_BAR();
#endif

    REPS(8) { PHASE_IDS
        const bf16_t* XB = (const bf16_t*)(ws + OFF_X1B); const bf16_t* Y = (const bf16_t*)(ws + OFF_Y);
        const int* TE = (const int*)(ws + OFF_TE); const int* TP = (const int*)(ws + OFF_TP); const float* TW = (const float*)(ws + OFF_TW);
        f32x4 gf[4];
#pragma unroll
        for (int i = 0; i < 4; ++i) gf[i] = *(const f32x4*)(p.norm_f_g + i * 256 + lane * 4);
        int tok = bid * 8 + wid;
        u32x2 te[2], tp[2]; f32x2 tw[2];
#pragma unroll
        for (int j = 0; j < 2; ++j) { const int t = tok + 2048 * j; te[j] = *(const u32x2*)(TE + t * 2); tp[j] = *(const u32x2*)(TP + t * 2); tw[j] = *(const f32x2*)(TW + t * 2); }
        for (; tok < T_TOK; tok += 4096) {
            u32x2 xa[2][4], ya[2][4], yb[2][4];
#pragma unroll
            for (int j = 0; j < 2; ++j) { const int t = tok + 2048 * j;
                const bf16_t* y0 = Y + (size_t)(tb[te[j].x] * 256 + (int)tp[j].x) * 1024; const bf16_t* y1 = Y + (size_t)(tb[te[j].y] * 256 + (int)tp[j].y) * 1024;
#pragma unroll
                for (int i = 0; i < 4; ++i) { const int c = i * 256 + lane * 4; xa[j][i] = *(const u32x2*)(XB + (size_t)t * 1024 + c); ya[j][i] = *(const u32x2*)(y0 + c); yb[j][i] = *(const u32x2*)(y1 + c); } }
            f32x2 twc[2] = {tw[0], tw[1]};
            { const int tn = tok + 4096 < T_TOK ? tok + 4096 : tok;
#pragma unroll
              for (int j = 0; j < 2; ++j) { const int t = tn + 2048 * j; te[j] = *(const u32x2*)(TE + t * 2); tp[j] = *(const u32x2*)(TP + t * 2); tw[j] = *(const f32x2*)(TW + t * 2); } }
#pragma unroll
            for (int j = 0; j < 2; ++j) { const int t = tok + 2048 * j; const float w0 = twc[j].x, w1 = twc[j].y;
                float v[16]; float ss = 0.f;
#pragma unroll
                for (int i = 0; i < 4; ++i) {
                    v[4 * i] = bf_lo(xa[j][i].x) + w0 * bf_lo(ya[j][i].x) + w1 * bf_lo(yb[j][i].x); v[4 * i + 1] = bf_hi(xa[j][i].x) + w0 * bf_hi(ya[j][i].x) + w1 * bf_hi(yb[j][i].x);
                    v[4 * i + 2] = bf_lo(xa[j][i].y) + w0 * bf_lo(ya[j][i].y) + w1 * bf_lo(yb[j][i].y); v[4 * i + 3] = bf_hi(xa[j][i].y) + w0 * bf_hi(ya[j][i].y) + w1 * bf_hi(yb[j][i].y);
                    ss += v[4 * i] * v[4 * i] + v[4 * i + 1] * v[4 * i + 1] + v[4 * i + 2] * v[4 * i + 2] + v[4 * i + 3] * v[4 * i + 3]; }
#pragma unroll
                for (int o = 32; o > 0; o >>= 1) ss += __shfl_xor(ss, o);
                const float rs = 1.0f / sqrtf(ss * (1.0f / 1024.0f) + EPSN);
#pragma unroll
                for (int i = 0; i < 4; ++i) { const int c = i * 256 + lane * 4;
                    f32x4 o; o[0] = v[4 * i] * rs * gf[i][0]; o[1] = v[4 * i + 1] * rs * gf[i][1]; o[2] = v[4 * i + 2] * rs * gf[i][2]; o[3] = v[4 * i + 3] * rs * gf[i][3];
                    *(f32x4*)(p.out + (size_t)t * 1024 + c) = o; } }
        }
    }
}

extern "C" void kernel_launch(void* const* d_in, const int* in_sizes, int n_in, void* d_out, int out_size, void* d_ws, size_t ws_size, hipStream_t stream) {
    static int grid = 0;
    if (grid == 0) {
        int dev = 0, cus = 0;
        if (hipGetDevice(&dev) != hipSuccess || hipDeviceGetAttribute(&cus, hipDeviceAttributeMultiprocessorCount, dev) != hipSuccess) { grid = -1; return; }
        if (hipFuncSetAttribute((const void*)hymba_fwd, hipFuncAttributeMaxDynamicSharedMemorySize, LDS_TOTAL) != hipSuccess) { grid = -1; return; }
        int per_cu = 0;
        (void)hipOccupancyMaxActiveBlocksPerMultiprocessor(&per_cu, (const void*)hymba_fwd, 512, LDS_TOTAL);
        (void)hipGetLastError();
        grid = cus < 256 ? cus : 256;
    }
    if (grid < 0) return;
    (void)hipMemsetAsync(d_ws, 0, CTL_ZERO, stream);
    Params p{};
    p.x = (const float*)d_in[0]; p.norm1_g = (const float*)d_in[1]; p.w_in = (const float*)d_in[2]; p.pe_kc = (const float*)d_in[3]; p.w_kc1 = (const float*)d_in[4]; p.w_kc2 = (const float*)d_in[5];
    p.pe_vc = (const float*)d_in[6]; p.w_vc1 = (const float*)d_in[7]; p.w_vc2 = (const float*)d_in[8]; p.w_o = (const float*)d_in[9]; p.norm2_g = (const float*)d_in[10];
    p.w_rg = (const float*)d_in[11]; p.b_rg = (const float*)d_in[12]; p.w_re = (const float*)d_in[13]; p.b_re = (const float*)d_in[14]; p.w_gate = (const float*)d_in[15]; p.w_up = (const float*)d_in[16]; p.w_down = (const float*)d_in[17]; p.norm_f_g = (const float*)d_in[18];
    p.out = (float*)d_out; p.ws = (unsigned char*)d_ws;
    hipLaunchKernelGGL(hymba_fwd, dim3(grid), dim3(512), LDS_TOTAL, stream, p);
}
```

```cpp
#include <hip/hip_runtime.h>
#include <stdint.h>
#include <math.h>

#ifndef EN_DIL
#define EN_DIL 1
#endif
#ifndef EN_NSA
#define EN_NSA 1
#endif
#ifndef EN_MOE
#define EN_MOE 1
#endif
#ifndef DBG_T1
#define DBG_T1 0
#endif
#ifndef DBG_T2
#define DBG_T2 0
#endif
#ifndef DBG_T3
#define DBG_T3 0
#endif
#ifndef DBG_T4
#define DBG_T4 0
#endif
#ifndef DBG_T5
#define DBG_T5 0
#endif
#ifndef DBG_T6
#define DBG_T6 0
#endif
#ifndef DBG_T8
#define DBG_T8 0
#endif
#ifndef GEMM_SAFE
#define GEMM_SAFE 0
#endif
#ifndef DBG_T9
#define DBG_T9 0
#endif
#ifndef DBG_TA
#define DBG_TA 0
#endif
#ifndef REP_PHASE
#define REP_PHASE -1
#endif
#define REPS(k) for (int rep_ = 0; rep_ < ((REP_PHASE == (k)) ? 2 : 1); ++rep_)
#ifndef DBG_LDSPOISON
#define DBG_LDSPOISON 0
#endif
#ifndef DBG_XBAR
#define DBG_XBAR 0
#endif
#ifndef SKEL
#define SKEL 0
#endif

#define DEV __device__ __forceinline__
#define LDS __attribute__((address_space(3)))
typedef LDS unsigned char* LDSP;
typedef unsigned short bf16_t;
typedef short bf16x8 __attribute__((ext_vector_type(8)));
typedef short s16x4 __attribute__((ext_vector_type(4)));
typedef float f32x16 __attribute__((ext_vector_type(16)));
typedef float f32x4 __attribute__((ext_vector_type(4)));
typedef unsigned u32x4 __attribute__((ext_vector_type(4)));
typedef unsigned u32x2 __attribute__((ext_vector_type(2)));
typedef float f32x2 __attribute__((ext_vector_type(2)));

#define MFMA32(a, b, c) __builtin_amdgcn_mfma_f32_32x32x16_bf16(a, b, c, 0, 0, 0)

constexpr int T_TOK = 65536, SEQ = 2048, DM = 1024;
constexpr int NPROJ = 2840, NPAD = 3072;
constexpr float SCQ = 0.125f * 1.4426950408889634f;
constexpr float EPSN = 1e-6f;

constexpr size_t MB = 1048576;
constexpr size_t OFF_BAR = 0, OFF_QUEUE = 28672, OFF_CNT = 20480, OFF_BIAS1 = 24576, CTL_ZERO = 32768;
constexpr size_t OFF_ROPEC = 1 * MB, OFF_ROPES = 1 * MB + 65536;
constexpr size_t OFF_SEL = 1 * MB + 131072;
constexpr size_t OFF_WINT = 2 * MB;
constexpr size_t OFF_WOT = OFF_WINT + (size_t)NPAD * 1024 * 2;
constexpr size_t OFF_WC1T = OFF_WOT + (size_t)1024 * 1024 * 2;
constexpr size_t OFF_WC2T = OFF_WC1T + (size_t)2 * 256 * 2048 * 2;
constexpr size_t OFF_WRT = OFF_WC2T + (size_t)2 * 256 * 256 * 2;
constexpr size_t OFF_WGUT = OFF_WRT + (size_t)2 * 128 * 1024 * 2;
constexpr size_t OFF_WDT = OFF_WGUT + (size_t)64 * 512 * 1024 * 2;
constexpr size_t OFF_LIST = OFF_WDT + (size_t)64 * 1024 * 256 * 2;
constexpr size_t OFF_TE = OFF_LIST + (size_t)64 * 65536 * 4;
constexpr size_t OFF_TP = OFF_TE + (size_t)T_TOK * 2 * 4;
constexpr size_t OFF_TW = OFF_TP + (size_t)T_TOK * 2 * 4;
constexpr size_t OFF_RSTD2 = OFF_TW + (size_t)T_TOK * 2 * 4;
constexpr size_t OFF_WEND = OFF_RSTD2 + (size_t)T_TOK * 4;
constexpr size_t OFF_R1 = 136 * MB;
constexpr size_t OFF_R2 = 264 * MB;
constexpr size_t OFF_QA = OFF_R2, OFF_KA = OFF_R2 + 64 * MB, OFF_VA = OFF_R2 + 128 * MB, OFF_QB = OFF_R2 + 192 * MB;
constexpr size_t OFF_KV6 = OFF_R2 + 256 * MB;
constexpr size_t OFF_GATE = OFF_R2 + 352 * MB;
constexpr size_t OFF_R3 = 622 * MB;
constexpr size_t OFF_OP = OFF_R3;
constexpr size_t OFF_LSE = OFF_R3 + 192 * MB;
constexpr size_t OFF_HID = OFF_R3 + 198 * MB;
constexpr size_t OFF_KC = OFF_R3 + 206 * MB;
constexpr size_t OFF_VC = OFF_R3 + 207 * MB;
constexpr size_t OFF_X1B = OFF_R2, OFF_X1L = OFF_R2 + 128 * MB;
constexpr size_t OFF_HE = OFF_R1;
constexpr size_t OFF_Y = OFF_R2 + 256 * MB;
static_assert(OFF_WEND <= OFF_R1, "weights region overflow");
static_assert(OFF_Y + (size_t)147456 * 1024 * 2 <= OFF_HID, "Y overlaps live data");

constexpr int LDS_GEMM = 131072;
constexpr int LDS_TB = LDS_GEMM;
constexpr int LDS_TOTAL = LDS_GEMM + 4096;

struct Params {
    const float* x; const float* norm1_g; const float* w_in; const float* pe_kc; const float* w_kc1; const float* w_kc2;
    const float* pe_vc; const float* w_vc1; const float* w_vc2; const float* w_o; const float* norm2_g;
    const float* w_rg; const float* b_rg; const float* w_re; const float* b_re; const float* w_gate; const float* w_up; const float* w_down; const float* norm_f_g;
    float* out; unsigned char* ws;
};

typedef __bf16 bf16v2 __attribute__((ext_vector_type(2)));
DEV unsigned cvt_pk(float lo, float hi) { bf16v2 v; v.x = (__bf16)lo; v.y = (__bf16)hi; return __builtin_bit_cast(unsigned, v); }
DEV float bf_lo(unsigned u) { return __uint_as_float(u << 16); }
DEV float bf_hi(unsigned u) { return __uint_as_float(u & 0xffff0000u); }
DEV float fexp2(float x) { return __builtin_amdgcn_exp2f(x); }
DEV int perm32(int rho) { const int g = rho >> 3, h = (rho >> 2) & 1, e = rho & 3; return 16 * (g >> 1) + 8 * h + 4 * (g & 1) + e; }
DEV int rope_src(int i) { return i < 16 ? ((i & 1) ? 8 + (i >> 1) : (i >> 1)) : i; }
DEV float xhalf_max(float v) { auto r = __builtin_amdgcn_permlane32_swap(__float_as_uint(v), __float_as_uint(v), false, false); return fmaxf(__uint_as_float(r[0]), __uint_as_float(r[1])); }
DEV float xhalf_sum(float v) { auto r = __builtin_amdgcn_permlane32_swap(__float_as_uint(v), __float_as_uint(v), false, false); return __uint_as_float(r[0]) + __uint_as_float(r[1]); }
DEV int opaque(int v) { asm volatile("" : "+v"(v)); return v; }
DEV int lds_off(int row, int chunk) { return row * 128 + ((chunk ^ ((row >> 1) & 7)) << 4); }

#define XB_TMO      128
#define XB_XCNT(j)  (256  + 64 * (j))
#define XB_XSUB(j)  (1280 + 64 * (j))
#define XB_XGEN(j)  (2304 + 64 * (j))
#define XB_TOP      3328
#define XB_TOPGEN   3392
#define XCD_BAR_WORDS 3456
#define XB_SPIN_CAP (1u << 18)
#define LAS __attribute__((address_space(3)))

__device__ __forceinline__ unsigned xb_ld(unsigned* p)              { return __hip_atomic_load(p, __ATOMIC_RELAXED, __HIP_MEMORY_SCOPE_AGENT); }
__device__ __forceinline__ unsigned xb_add(unsigned* p, unsigned v) { return __hip_atomic_fetch_add(p, v, __ATOMIC_RELAXED, __HIP_MEMORY_SCOPE_AGENT); }
__device__ __forceinline__ unsigned xb_xcc_id() { return (unsigned)__builtin_amdgcn_s_getreg((3 << 11) | 20) & 0xFu; }
#define XB_SPIN(cond, bar) do { unsigned _sp = 0; while (cond) { __builtin_amdgcn_s_sleep(1); \
    if ((++_sp & 255u) == 0u) { if (xb_ld(&(bar)[XB_TMO])) break; if (_sp > XB_SPIN_CAP) { atomicAdd(&(bar)[XB_TMO], 1u); break; } } } } while (0)

struct XcdBarrier { unsigned* bar; unsigned x; volatile LAS unsigned* st; };

__device__ __forceinline__ XcdBarrier xcd_barrier_post(unsigned* bar, volatile LAS unsigned* st) {
    XcdBarrier b; b.bar = bar; b.x = xb_xcc_id(); b.st = st;
    if (threadIdx.x == 0) (void)xb_add(&bar[XB_XCNT(b.x)], 1u);
    return b;
}
__device__ __forceinline__ void xcd_barrier_complete(unsigned* bar, unsigned x, unsigned& nloc, unsigned& nx) {
    const unsigned G = gridDim.x * gridDim.y * gridDim.z;
    unsigned sum, cnt, mine, sp = 0u;
    for (;;) {
        sum = 0u; cnt = 0u; mine = 0u;
#pragma unroll
        for (unsigned j = 0; j < 16; ++j) { const unsigned c = xb_ld(&bar[XB_XCNT(j)]); sum += c; cnt += (c > 0u) ? 1u : 0u; mine = (j == x) ? c : mine; }
        if (sum == G) break;
        __builtin_amdgcn_s_sleep(1);
        if ((++sp & 255u) == 0u) { if (xb_ld(&bar[XB_TMO])) break; if (sp > XB_SPIN_CAP) { atomicAdd(&bar[XB_TMO], 1u); break; } }
    }
    nloc = mine > 0u ? mine : 1u; nx = cnt > 0u ? cnt : 1u;
}
__device__ __forceinline__ void xcd_barrier_impl(const XcdBarrier& b) {
    asm volatile("s_waitcnt vmcnt(0)" ::: "memory");
    __syncthreads();
    if (threadIdx.x == 0) {
        unsigned* bar = b.bar;
        __builtin_amdgcn_s_waitcnt(0);
        unsigned nloc = b.st[0], nx = b.st[1];
        if (nloc == 0u) { xcd_barrier_complete(bar, b.x, nloc, nx); b.st[0] = nloc; b.st[1] = nx; }
        const unsigned old = xb_add(&bar[XB_XSUB(b.x)], 1u);
        const unsigned gen = old / nloc;
        if (old + 1u == (gen + 1u) * nloc) {
            __builtin_amdgcn_fence(__ATOMIC_RELEASE, "agent");
            asm volatile("s_waitcnt vmcnt(0)" ::: "memory");
            const unsigned og = xb_add(&bar[XB_TOP], 1u);
            const unsigned tg = og / nx;
            if (og + 1u == (tg + 1u) * nx) xb_add(&bar[XB_TOPGEN], 1u);
            else XB_SPIN(xb_ld(&bar[XB_TOPGEN]) == tg, bar);
            __builtin_amdgcn_fence(__ATOMIC_ACQUIRE, "agent");
            xb_add(&bar[XB_XGEN(b.x)], 1u);
            asm volatile("s_waitcnt vmcnt(0)" ::: "memory");
        } else {
            XB_SPIN(xb_ld(&bar[XB_XGEN(b.x)]) == gen, bar);
            __builtin_amdgcn_fence(__ATOMIC_ACQUIRE, "agent");
            asm volatile("s_waitcnt vmcnt(0)" ::: "memory");
        }
    }
    __syncthreads();
}

DEV void xcd_barrier(unsigned* barw, volatile LAS unsigned* st) { XcdBarrier b; b.bar = barw; b.x = xb_xcc_id(); b.st = st; xcd_barrier_impl(b); }

template <class F>
DEV void tr_matrix(const F f, bf16_t* dst, int NR, int K, int lomode, LDSP lds) {
    LDS float* tile = (LDS float*)lds;
    const int tid = threadIdx.x, tk = K >> 6, nt = (NR >> 6) * tk;
    for (int t = blockIdx.x; t < nt; t += gridDim.x) {
        const int n0 = (t / tk) << 6, k0 = (t % tk) << 6;
#pragma unroll
        for (int i = 0; i < 8; ++i) { const int kk = (tid >> 6) + 8 * i, nn = tid & 63; tile[kk * 65 + nn] = f(n0 + nn, k0 + kk); }
        __syncthreads();
        {
            const int nn = tid >> 3, k8 = (tid & 7) * 8; float v[8];
#pragma unroll
            for (int j = 0; j < 8; ++j) { v[j] = tile[(k8 + j) * 65 + nn]; if (lomode) v[j] = v[j] - bf_lo(cvt_pk(v[j], 0.f) & 0xffffu); }
            u32x4 w; w.x = cvt_pk(v[0], v[1]); w.y = cvt_pk(v[2], v[3]); w.z = cvt_pk(v[4], v[5]); w.w = cvt_pk(v[6], v[7]);
            *(u32x4*)(dst + (size_t)(n0 + nn) * K + k0 + k8) = w;
        }
        __syncthreads();
    }
}
struct SrcWin { const float* w; const float* g1;
    DEV float operator()(int R, int k) const {
        const int c = R;
        if (c >= NPROJ) return 0.f;
        const bool rp = (c < 1024) || (c >= 1536 && c < 2048) || (c >= 2304 && c < 2432) || (c >= 2560 && c < 2688);
        const int src = rp ? (c & ~63) + rope_src(c & 63) : c;
        const float sc = (c < 512 || (c >= 1536 && c < 2048)) ? SCQ : 1.f;
        return w[(size_t)k * NPROJ + src] * g1[k] * sc; } };
struct SrcWo { const float* w; DEV float operator()(int R, int k) const { return w[(size_t)k * 1024 + R]; } };
DEV const float* psel(const float* a, const float* b, int pick_b) { return (const float*)((uintptr_t)a + (pick_b ? ((uintptr_t)b - (uintptr_t)a) : (uintptr_t)0)); }
struct SrcWc1 { const float* wk; const float* wv; DEV float operator()(int R, int k) const { const float* w = psel(wk, wv, R >> 8); const int r = R & 255; return w[(size_t)k * 256 + r]; } };
struct SrcWc2 { const float* wk; const float* wv;
    DEV float operator()(int R, int k) const { const int kv = R >> 8, r = R & 255, c = r; if (c >= 64) return 0.f;
        return psel(wk, wv, kv)[(size_t)k * 64 + (kv ? c : rope_src(c))]; } };
struct SrcWr { const float* wrg; const float* wre; const float* g2;
    DEV float operator()(int R, int k) const { if (R >= 96) return 0.f; const int c = (R & ~31) + perm32(R & 31), lb = c >> 3, ix = c & 7;
        if (lb > 8) return 0.f; const size_t off = lb == 0 ? (size_t)k * 8 + ix : (size_t)k * 64 + (lb - 1) * 8 + ix; return psel(wrg, wre, lb != 0)[off] * g2[k]; } };
struct SrcWgu { const float* wg; const float* wu; const float* g2;
    DEV float operator()(int R, int k) const { const int e = R >> 9, r = R & 511, pn = r >> 8, bj = (r >> 7) & 1, j = pn * 128 + (r & 127);
        const float* w = psel(wg, wu, bj); return w[((size_t)e * 1024 + k) * 256 + j] * g2[k]; } };
struct SrcWd { const float* w; DEV float operator()(int R, int k) const { const int e = R >> 10, r = R & 1023, sl = r & 255, col = (r & ~255) + ((sl >> 5) & 3) * 64 + (sl >> 7) * 32 + (sl & 31); return w[((size_t)e * 256 + k) * 1024 + col]; } };

DEV void p0_prologue(const Params& p, LDSP lds) {
    unsigned char* ws = p.ws;
    const int tid = threadIdx.x, lane = tid & 63, wid = tid >> 6, bid = blockIdx.x;
    { const int idx = bid * 512 + tid; if (idx < 2048 * 8) { const int pos = idx >> 3, pp = idx & 7;
        const float invf = (float)pow(500000.0, -(double)pp / 8.0); const float ang = (float)pos * invf;
        ((float*)(ws + OFF_ROPEC))[idx] = (float)cos((double)ang); ((float*)(ws + OFF_ROPES))[idx] = (float)sin((double)ang); } }
    if (bid < 16) { const int kv = bid & 1, jb = (bid >> 1) * 32, j = jb + (tid & 31), part = tid >> 5; const float* pe = psel(p.pe_kc, p.pe_vc, kv); const float* w1 = psel(p.w_kc1, p.w_vc1, kv);
        float a = 0.f; const int k0 = part * 128;
        for (int kk = k0; kk < k0 + 128; ++kk) a += pe[kk] * w1[(size_t)kk * 256 + j];
        LDS float* red = (LDS float*)lds; red[part * 32 + (tid & 31)] = a;
        __syncthreads();
        if (tid < 32) { float t = 0.f; for (int q = 0; q < 16; ++q) t += red[q * 32 + tid]; ((float*)(ws + OFF_BIAS1))[kv * 256 + jb + tid] = t; }
        __syncthreads(); }
    { bf16_t* HB = (bf16_t*)(ws + OFF_R1);
      for (int row = bid * 8 + wid; row < T_TOK; row += 8192) {
        f32x4 v[4][4]; float ss[4];
#pragma unroll
        for (int j = 0; j < 4; ++j) { const float* xr = p.x + (size_t)(row + 2048 * j) * 1024;
#pragma unroll
          for (int i = 0; i < 4; ++i) v[j][i] = *(const f32x4*)(xr + i * 256 + lane * 4); }
#pragma unroll
        for (int j = 0; j < 4; ++j) { ss[j] = 0.f;
#pragma unroll
          for (int i = 0; i < 4; ++i) ss[j] += v[j][i][0] * v[j][i][0] + v[j][i][1] * v[j][i][1] + v[j][i][2] * v[j][i][2] + v[j][i][3] * v[j][i][3]; }
#pragma unroll
        for (int o = 32; o > 0; o >>= 1) {
#pragma unroll
          for (int j = 0; j < 4; ++j) ss[j] += __shfl_xor(ss[j], o); }
#pragma unroll
        for (int j = 0; j < 4; ++j) { const float rs = 1.0f / sqrtf(ss[j] * (1.0f / 1024.0f) + EPSN);
#pragma unroll
          for (int i = 0; i < 4; ++i) { u32x2 w; w.x = cvt_pk(v[j][i][0] * rs, v[j][i][1] * rs); w.y = cvt_pk(v[j][i][2] * rs, v[j][i][3] * rs); *(u32x2*)(HB + (size_t)(row + 2048 * j) * 1024 + i * 256 + lane * 4) = w; } }
      } }
    tr_matrix(SrcWin{p.w_in, p.norm1_g}, (bf16_t*)(ws + OFF_WINT), NPAD, 1024, 0, lds);
    tr_matrix(SrcWo{p.w_o}, (bf16_t*)(ws + OFF_WOT), 1024, 1024, 0, lds);
    tr_matrix(SrcWc1{p.w_kc1, p.w_vc1}, (bf16_t*)(ws + OFF_WC1T), 512, 2048, 0, lds);
    tr_matrix(SrcWc2{p.w_kc2, p.w_vc2}, (bf16_t*)(ws + OFF_WC2T), 512, 256, 0, lds);
    tr_matrix(SrcWr{p.w_rg, p.w_re, p.norm2_g}, (bf16_t*)(ws + OFF_WRT), 128, 1024, 0, lds);
    tr_matrix(SrcWr{p.w_rg, p.w_re, p.norm2_g}, (bf16_t*)(ws + OFF_WRT) + 128 * 1024, 128, 1024, 1, lds);
    tr_matrix(SrcWgu{p.w_gate, p.w_up, p.norm2_g}, (bf16_t*)(ws + OFF_WGUT), 64 * 512, 1024, 0, lds);
    tr_matrix(SrcWd{p.w_down}, (bf16_t*)(ws + OFF_WDT), 64 * 1024, 256, 0, lds);
}

#define GLDS16(src, dstoff) __builtin_amdgcn_global_load_lds((const unsigned*)(src), (LDS unsigned*)(lds + (dstoff)), 16, 0, 0)
namespace pg {
constexpr int BM = 256, BK = 64, HALF = 128, HTB = HALF * BK * 2, STAGE_BYTES = 8 * HTB;
DEV int lds_byte(int r, int c) { const int st = (r >> 4) * 2 + (c >> 5), rr = r & 15, cc = c & 31, ob = rr * 64 + cc * 2; return st * 1024 + (ob ^ (((ob >> 9) & 1) << 5)); }
DEV void stage_rc(int b, int& R, int& C) { const int st = b / 1024, sb = b % 1024, swz = sb ^ (((sb >> 9) & 1) << 5); R = (st >> 1) * 16 + swz / 64; C = (st & 1) * 32 + (swz % 64) / 2; }
DEV int pg_perm32(int rho) { const int n = rho >> 4, i = rho & 15; return 8 * (i >> 2) + 4 * n + (i & 3); }
struct Unit { const char* a; const char* b; int pm, pn, x0, x1, x2; };
typedef f32x4 Acc[2][2][4][2];

template <class Epi, class Sched, bool ALIGN_EPI, bool GATHER>
DEV void gemm_phase(LDSP lds, int K_, int lda, const Sched& S, const Epi& E) {
    int K = K_; asm volatile("" : "+s"(K));
    const int tid = opaque((int)threadIdx.x), wid = __builtin_amdgcn_readfirstlane(tid >> 6), lane = tid & 63, wr = wid >> 2, wc = wid & 3, fr = lane & 15, fq = lane >> 4;
    const int nt = K / BK;
    Unit cur, nxt; int ui = 0;
    if (!S.next(0, cur)) return;
    unsigned voffA0[2], voffA1[2], voffB[2], nvA0[2], nvA1[2]; int sR[2], sC[2];
#pragma unroll
    for (int i = 0; i < 2; ++i) { int R, C; stage_rc(tid * 16 + i * 8192, R, C); sR[i] = R; sC[i] = C; const int Rb = (R & ~31) + pg_perm32(R & 31);
        if constexpr (GATHER) { voffA0[i] = (S.arow(cur, R) + (unsigned)C) * 2u; voffA1[i] = (S.arow(cur, R + HALF) + (unsigned)C) * 2u; }
        else { voffA0[i] = (unsigned)(R * lda + C) * 2u; voffA1[i] = (unsigned)((R + HALF) * lda + C) * 2u; }
        nvA0[i] = voffA0[i]; nvA1[i] = voffA1[i];
        voffB[i] = (unsigned)(Rb * K + C) * 2u; }
    const size_t kstep = (size_t)(BK * 2);
    const size_t hstepB = (size_t)HALF * K * 2;
    const unsigned ldsw = (unsigned)wid * 1024u;
    const int aoff = lds_byte(wr * 64 + fr, fq * 8), boff = lds_byte(wc * 32 + fr, fq * 8);
#define PG_SA(b, h) (((b) * 2 + (h)) * HTB)
#define PG_SB(b, h) ((4 + (b) * 2 + (h)) * HTB)
#define PG_STAGE(bufoff, gbase, voff) do { _Pragma("unroll") for (int _i = 0; _i < 2; ++_i) GLDS16((const char*)(gbase) + (voff)[_i], (bufoff) + ldsw + _i * 8192); } while (0)
#define PG_LDA(dst, b, h) do { _Pragma("unroll") for (int m = 0; m < 4; ++m) _Pragma("unroll") for (int k = 0; k < 2; ++k) dst[m][k] = *(const LDS bf16x8*)(lds + PG_SA(b, h) + aoff + m * 2048 + k * 1024); } while (0)
#define PG_LDB(dst, b, h) do { _Pragma("unroll") for (int n = 0; n < 2; ++n) _Pragma("unroll") for (int k = 0; k < 2; ++k) dst[n][k] = *(const LDS bf16x8*)(lds + PG_SB(b, h) + boff + n * 2048 + k * 1024); } while (0)
#define PG_MMA(ai, bj, At, Bt) do { __builtin_amdgcn_s_setprio(1); _Pragma("unroll") for (int m = 0; m < 4; ++m) _Pragma("unroll") for (int n = 0; n < 2; ++n) _Pragma("unroll") for (int k = 0; k < 2; ++k) \
        acc[ai][bj][m][n] = __builtin_amdgcn_mfma_f32_16x16x32_bf16(Bt[n][k], At[m][k], acc[ai][bj][m][n], 0, 0, 0); __builtin_amdgcn_s_setprio(0); } while (0)
#define PG_WAIT_V(n) asm volatile("s_waitcnt vmcnt(" #n ")" ::: "memory")
#define PG_WAIT_L(n) asm volatile("s_waitcnt lgkmcnt(" #n ")" ::: "memory")
#define PG_BAR __builtin_amdgcn_s_barrier()
#define PG_SCHED __builtin_amdgcn_sched_barrier(0)
    Acc acc;
#pragma unroll
    for (int a = 0; a < 2; ++a)
#pragma unroll
        for (int b = 0; b < 2; ++b)
#pragma unroll
            for (int m = 0; m < 4; ++m)
#pragma unroll
                for (int n = 0; n < 2; ++n) acc[a][b][m][n] = (f32x4){0.f, 0.f, 0.f, 0.f};
    bf16x8 At[4][2], B0[2][2], B1[2][2];
    const char* cA = cur.a; const char* cB = cur.b;
    PG_STAGE(PG_SB(0, 0), cB, voffB); PG_STAGE(PG_SB(0, 1), cB + hstepB, voffB); PG_STAGE(PG_SA(0, 0), cA, voffA0); PG_STAGE(PG_SA(0, 1), cA, voffA1);
    if (wr == 1) PG_BAR;
    PG_WAIT_V(2); PG_BAR;
    PG_STAGE(PG_SB(1, 0), cB + kstep, voffB); PG_STAGE(PG_SA(1, 0), cA + kstep, voffA0); PG_STAGE(PG_SB(1, 1), cB + hstepB + kstep, voffB);
    PG_WAIT_V(6); PG_BAR;
    for (;;) {
        const bool has_next = S.next(ui + 1, nxt);
        const char* nA = has_next ? nxt.a : cA; const char* nB = has_next ? nxt.b : cB;
        if constexpr (GATHER) { if (has_next) {
#pragma unroll
            for (int i = 0; i < 2; ++i) { nvA0[i] = (S.arow(nxt, sR[i]) + (unsigned)sC[i]) * 2u; nvA1[i] = (S.arow(nxt, sR[i] + HALF) + (unsigned)sC[i]) * 2u; } } }
        for (int t = 0; t < nt; t += 2) {
            const bool last = (t == nt - 2);
            const char* a1 = cA + (size_t)(t + 1) * kstep;
            const char* a2 = last ? nA : cA + (size_t)(t + 2) * kstep; const char* b2 = last ? nB : cB + (size_t)(t + 2) * kstep;
            const char* a3 = a2 + kstep; const char* b3 = b2 + kstep;
            unsigned w0[2], w1[2];
#pragma unroll
            for (int i = 0; i < 2; ++i) { w0[i] = (GATHER && last) ? nvA0[i] : voffA0[i]; w1[i] = (GATHER && last) ? nvA1[i] : voffA1[i]; }
            PG_LDB(B0, 0, 0); PG_LDB(B1, 0, 1); PG_SCHED; PG_LDA(At, 0, 0); PG_STAGE(PG_SA(1, 1), a1, voffA1);
            PG_WAIT_V(8); PG_WAIT_L(0); PG_BAR; PG_MMA(0, 0, At, B0); PG_MMA(0, 1, At, B1); PG_BAR; PG_SCHED;
            PG_LDA(At, 0, 1); PG_STAGE(PG_SB(0, 0), b2, voffB); PG_STAGE(PG_SB(0, 1), b2 + hstepB, voffB); PG_STAGE(PG_SA(0, 0), a2, w0);
            PG_WAIT_V(8); PG_WAIT_L(0); PG_BAR; PG_MMA(1, 0, At, B0); PG_MMA(1, 1, At, B1); PG_BAR; PG_SCHED;
            PG_LDB(B0, 1, 0); PG_LDB(B1, 1, 1); PG_SCHED; PG_LDA(At, 1, 0); PG_STAGE(PG_SA(0, 1), a2, w1);
            PG_WAIT_V(8); PG_WAIT_L(0); PG_BAR; PG_MMA(0, 0, At, B0); PG_MMA(0, 1, At, B1); PG_BAR; PG_SCHED;
            PG_LDA(At, 1, 1); PG_STAGE(PG_SB(1, 0), b3, voffB); PG_STAGE(PG_SB(1, 1), b3 + hstepB, voffB); PG_STAGE(PG_SA(1, 0), a3, w0);
            PG_WAIT_V(8); PG_WAIT_L(0); PG_BAR; PG_MMA(1, 0, At, B0); PG_MMA(1, 1, At, B1); PG_BAR; PG_SCHED;
        }
        if constexpr (ALIGN_EPI) { if (wr == 0) PG_BAR; }
        E(acc, cur, wr, wc, fr, fq);
        if (!has_next) break;
#pragma unroll
        for (int a = 0; a < 2; ++a)
#pragma unroll
            for (int b = 0; b < 2; ++b)
#pragma unroll
                for (int m = 0; m < 4; ++m)
#pragma unroll
                    for (int n = 0; n < 2; ++n) acc[a][b][m][n] = (f32x4){0.f, 0.f, 0.f, 0.f};
        cur = nxt; cA = nA; cB = nB; ++ui;
        if constexpr (GATHER) {
#pragma unroll
            for (int i = 0; i < 2; ++i) { voffA0[i] = nvA0[i]; voffA1[i] = nvA1[i]; } }
        if constexpr (ALIGN_EPI) { if (wr == 1) PG_BAR; }
    }
    PG_WAIT_V(0);
    if constexpr (!ALIGN_EPI) { if (wr == 0) PG_BAR; }
    PG_BAR;
#undef PG_SA
#undef PG_SB
#undef PG_STAGE
#undef PG_LDA
#undef PG_LDB
#undef PG_MMA
#undef PG_WAIT_V
#undef PG_WAIT_L
#undef PG_BAR
#undef PG_SCHED
}
}

DEV u32x4 pack8(const float (&v)[8]) { u32x4 w; w.x = cvt_pk(v[0], v[1]); w.y = cvt_pk(v[2], v[3]); w.z = cvt_pk(v[4], v[5]); w.w = cvt_pk(v[6], v[7]); return w; }
#define PACC8(v, acc, ai, bj, m) { _Pragma("unroll") for (int _e = 0; _e < 4; ++_e) { v[_e] = acc[ai][bj][m][0][_e]; v[4 + _e] = acc[ai][bj][m][1][_e]; } }

struct OrderXcd { const char* A; const char* Bt; size_t astep, bstep; int NT, rounds, xcd, ci;
    DEV bool next(int i, pg::Unit& u) const { if (i >= rounds) return false; const int q = i * 32 + ci, per = 4 * NT, mg = q / per, rem = q % per;
        u.pn = rem >> 2; u.pm = xcd * 32 + mg * 4 + (rem & 3); u.a = A + (size_t)u.pm * astep; u.b = Bt + (size_t)u.pn * bstep; u.x0 = 0; u.x1 = 0; u.x2 = 0; return true; } };
struct OrderOne { pg::Unit u;
    DEV bool next(int i, pg::Unit& o) const { if (i) return false; o = u; return true; } };
struct OrderMoe1 { const char* X; const char* WGU; const unsigned* LISTB; const unsigned* cntp; LDS const int* tb; int ntile, bid;
    DEV bool next(int i, pg::Unit& u) const { const int q = bid + 256 * i; if (q >= ntile * 2) return false; const int rt = q >> 1, nt = q & 1, e = __builtin_amdgcn_readfirstlane(tb[128 + rt]);
        u.pm = rt; u.pn = nt; u.x0 = e; u.x1 = (rt - __builtin_amdgcn_readfirstlane(tb[e])) * 256; u.x2 = (int)cntp[e]; u.a = X; u.b = WGU + (size_t)(e * 512 + nt * 256) * 1024 * 2; return true; }
    DEV unsigned arow(const pg::Unit& u, int r) const { const int pos = u.x1 + r; return (pos < u.x2 ? (LISTB[(size_t)u.x0 * 65536 + pos] >> 1) : 0u) * 1024u; } };
struct OrderMoe2 { const char* HE; const char* WDT; LDS const int* tb; int ntile, bid;
    DEV bool next(int i, pg::Unit& u) const { const int q = bid + 256 * i; if (q >= ntile * 4) return false; const int rt = q >> 2, nt = q & 3, e = __builtin_amdgcn_readfirstlane(tb[128 + rt]);
        u.pm = rt; u.pn = nt; u.x0 = e; u.x1 = 0; u.x2 = 0; u.a = HE + (size_t)rt * 256 * 256 * 2; u.b = WDT + (size_t)(e * 1024 + nt * 256) * 256 * 2; return true; } };

struct EpiInProj { unsigned char* ws;
    DEV void operator()(const pg::Acc& acc, const pg::Unit& u, int wr, int wc, int fr, int fq) const {
        const float* rc = (const float*)(ws + OFF_ROPEC); const float* rsn = (const float*)(ws + OFF_ROPES);
        const int tok0 = u.pm * 256 + wr * 64 + fr, b = tok0 >> 11, s0 = tok0 & 2047;
#pragma unroll
        for (int bj = 0; bj < 2; ++bj) {
            const int cu = u.pn * 256 + bj * 128 + wc * 32;
            const int c = cu + 8 * fq;
            if (cu >= 2816) {
                if (c < NPROJ) {
#pragma unroll
                    for (int ai = 0; ai < 2; ++ai)
#pragma unroll
                        for (int m = 0; m < 4; ++m) { const int tok = tok0 + ai * 128 + m * 16; float v[8]; PACC8(v, acc, ai, bj, m);
                            float* g = (float*)(ws + OFF_GATE) + (size_t)tok * 24 + (c - 2816); f32x4 a, d;
#pragma unroll
                            for (int i = 0; i < 4; ++i) { a[i] = 1.f / (1.f + __expf(-v[i])); d[i] = 1.f / (1.f + __expf(-v[4 + i])); }
                            *(f32x4*)g = a; *(f32x4*)(g + 4) = d; } }
                continue;
            }
            size_t base; int head, nh; bool rp;
            if (cu < 2048) { const int reg = cu >> 9; base = OFF_R2 + (size_t)reg * (64 * MB); head = (cu & 511) >> 6; nh = 8; rp = (reg != 2); }
            else { const int reg = (cu - 2048) >> 7; base = OFF_KV6 + (size_t)reg * (16 * MB); head = ((cu - 2048) & 127) >> 6; nh = 2; rp = (reg == 2 || reg == 4); }
            bf16_t* dst0 = (bf16_t*)(ws + base) + ((size_t)(b * nh + head) * 2048 + s0) * 64 + (c & 63);
            if (rp && (cu & 63) == 0) {
                const int p0 = (c & 31) >> 1;
                f32x4 cs[8], sn[8];
#pragma unroll
                for (int q = 0; q < 8; ++q) { const int srow = s0 + (q >> 2) * 128 + (q & 3) * 16; cs[q] = *(const f32x4*)(rc + srow * 8 + (p0 & 4)); sn[q] = *(const f32x4*)(rsn + srow * 8 + (p0 & 4)); }
#pragma unroll
                for (int q = 0; q < 8; ++q) { const int ai = q >> 2, m = q & 3; float v[8]; PACC8(v, acc, ai, bj, m);
                    if (fq < 2) {
#pragma unroll
                        for (int pr = 0; pr < 4; ++pr) { const float x1 = v[2 * pr], x2 = v[2 * pr + 1]; v[2 * pr] = x1 * cs[q][pr] - x2 * sn[q][pr]; v[2 * pr + 1] = x2 * cs[q][pr] + x1 * sn[q][pr]; } }
                    *(u32x4*)(dst0 + (size_t)(ai * 128 + m * 16) * 64) = pack8(v); }
            } else {
#pragma unroll
                for (int q = 0; q < 8; ++q) { const int ai = q >> 2, m = q & 3; float v[8]; PACC8(v, acc, ai, bj, m);
                    *(u32x4*)(dst0 + (size_t)(ai * 128 + m * 16) * 64) = pack8(v); }
            }
        }
    }
};

DEV float gelu_tanh(float x) { const float u = 0.7978845608028654f * (x + 0.044715f * x * x * x); return 0.5f * x * (1.f + tanhf(u)); }
struct EpiCmp1 { unsigned char* ws; int kv;
    DEV void operator()(const pg::Acc& acc, const pg::Unit& u, int wr, int wc, int fr, int fq) const {
        const float* bias = (const float*)(ws + OFF_BIAS1) + kv * 256;
        bf16_t* HID = (bf16_t*)(ws + OFF_HID) + (size_t)kv * 8192 * 256;
#pragma unroll
        for (int ai = 0; ai < 2; ++ai)
#pragma unroll
            for (int m = 0; m < 4; ++m) { const int R = u.pm * 256 + ai * 128 + wr * 64 + m * 16 + fr;
#pragma unroll
                for (int bj = 0; bj < 2; ++bj) { const int n = bj * 128 + wc * 32 + 8 * fq; float v[8]; PACC8(v, acc, ai, bj, m);
#pragma unroll
                    for (int i = 0; i < 8; ++i) v[i] = gelu_tanh(v[i] + bias[n + i]);
                    *(u32x4*)(HID + (size_t)R * 256 + n) = pack8(v); } }
    }
};
struct EpiCmp2 { unsigned char* ws; int kv;
    DEV void operator()(const pg::Acc& acc, const pg::Unit& u, int wr, int wc, int fr, int fq) const {
        if (wc >= 2) return;
        const float* rc = (const float*)(ws + OFF_ROPEC); const float* rsn = (const float*)(ws + OFF_ROPES);
        bf16_t* OUT = (bf16_t*)(ws + (kv ? OFF_VC : OFF_KC));
#pragma unroll
        for (int ai = 0; ai < 2; ++ai)
#pragma unroll
            for (int m = 0; m < 4; ++m) { const int R = u.pm * 256 + ai * 128 + wr * 64 + m * 16 + fr, cidx = R & 127;
                const int n = wc * 32 + 8 * fq; float v[8]; PACC8(v, acc, ai, 0, m);
                if (kv == 0 && n < 16) { const int pos = (cidx < 127 ? cidx : 126) * 16 + 31, p0 = n >> 1;
                    const f32x4 cs = *(const f32x4*)(rc + pos * 8 + p0), sn = *(const f32x4*)(rsn + pos * 8 + p0);
#pragma unroll
                    for (int pr = 0; pr < 4; ++pr) { const float x1 = v[2 * pr], x2 = v[2 * pr + 1]; v[2 * pr] = x1 * cs[pr] - x2 * sn[pr]; v[2 * pr + 1] = x2 * cs[pr] + x1 * sn[pr]; } }
                if (cidx == 127) {
#pragma unroll
                    for (int i = 0; i < 8; ++i) v[i] = 0.f; }
                *(u32x4*)(OUT + (size_t)R * 64 + n) = pack8(v); }
    }
};

struct EpiOut { unsigned char* ws; const float* x;
    DEV void operator()(const pg::Acc& acc, const pg::Unit& u, int wr, int wc, int fr, int fq) const {
        bf16_t* XB = (bf16_t*)(ws + OFF_X1B); bf16_t* XL = (bf16_t*)(ws + OFF_X1L);
#pragma unroll
        for (int ai = 0; ai < 2; ++ai)
#pragma unroll
            for (int m = 0; m < 4; ++m) { const int tok = u.pm * 256 + ai * 128 + wr * 64 + m * 16 + fr;
#pragma unroll
                for (int bj = 0; bj < 2; ++bj) { const int n = u.pn * 256 + bj * 128 + wc * 32 + 8 * fq; float v[8], lo[8]; PACC8(v, acc, ai, bj, m);
                    const f32x4 xa = *(const f32x4*)(x + (size_t)tok * 1024 + n), xb = *(const f32x4*)(x + (size_t)tok * 1024 + n + 4);
#pragma unroll
                    for (int i = 0; i < 4; ++i) { v[i] += xa[i]; v[4 + i] += xb[i]; }
                    const u32x4 h = pack8(v);
                    lo[0] = v[0] - bf_lo(h.x); lo[1] = v[1] - bf_hi(h.x); lo[2] = v[2] - bf_lo(h.y); lo[3] = v[3] - bf_hi(h.y);
                    lo[4] = v[4] - bf_lo(h.z); lo[5] = v[5] - bf_hi(h.z); lo[6] = v[6] - bf_lo(h.w); lo[7] = v[7] - bf_hi(h.w);
                    *(u32x4*)(XB + (size_t)tok * 1024 + n) = h; *(u32x4*)(XL + (size_t)tok * 1024 + n) = pack8(lo); } }
    }
};

struct EpiMoe1 { unsigned char* ws;
    DEV void operator()(const pg::Acc& acc, const pg::Unit& u, int wr, int wc, int fr, int fq) const {
        const float* RS = (const float*)(ws + OFF_RSTD2); bf16_t* HE = (bf16_t*)(ws + OFF_HE); const unsigned* list = (const unsigned*)(ws + OFF_LIST) + (size_t)u.x0 * 65536;
#pragma unroll
        for (int ai = 0; ai < 2; ++ai)
#pragma unroll
            for (int m = 0; m < 4; ++m) { const int lr = ai * 128 + wr * 64 + m * 16 + fr, pos = u.x1 + lr; const int tok = pos < u.x2 ? (int)(list[pos] >> 1) : 0; const float r = RS[tok];
                const int j = u.pn * 128 + wc * 32 + 8 * fq; float g[8], up[8], v[8]; PACC8(g, acc, ai, 0, m); PACC8(up, acc, ai, 1, m);
#pragma unroll
                for (int i = 0; i < 8; ++i) { const float a = g[i] * r; v[i] = a / (1.f + __expf(-a)) * (up[i] * r); }
                *(u32x4*)(HE + (size_t)(u.pm * 256 + lr) * 256 + j) = pack8(v); }
    }
};
struct EpiMoe2 { unsigned char* ws;
    DEV void operator()(const pg::Acc& acc, const pg::Unit& u, int wr, int wc, int fr, int fq) const {
        bf16_t* Y = (bf16_t*)(ws + OFF_Y);
        const bool lowr = fr < 8;
        const int col = u.pn * 256 + wc * 64 + (fr >> 3) * 32 + 8 * fq;
#pragma unroll
        for (int ai = 0; ai < 2; ++ai)
#pragma unroll
            for (int m = 0; m < 4; ++m) { const int rb = u.pm * 256 + ai * 128 + wr * 64 + m * 16 + (fr & 7);
                float v0[8], v1[8]; PACC8(v0, acc, ai, 0, m); PACC8(v1, acc, ai, 1, m);
                const u32x4 p0 = pack8(v0), p1 = pack8(v1);
                u32x4 snd, rcv;
#pragma unroll
                for (int i = 0; i < 4; ++i) { snd[i] = lowr ? p1[i] : p0[i]; rcv[i] = (unsigned)__builtin_amdgcn_update_dpp(0, (int)snd[i], 0x128  , 0xf, 0xf, false); }
                u32x4 sx, sy;
#pragma unroll
                for (int i = 0; i < 4; ++i) { sx[i] = lowr ? p0[i] : rcv[i]; sy[i] = lowr ? rcv[i] : p1[i]; }
                __builtin_nontemporal_store(sx, (u32x4*)(Y + (size_t)rb * 1024 + col));
                __builtin_nontemporal_store(sy, (u32x4*)(Y + (size_t)(rb + 8) * 1024 + col)); }
    }
};

struct Flash { f32x16 o0, o1; float m, l; };
DEV void flash_init(Flash& s) {
#pragma unroll
    for (int i = 0; i < 16; ++i) { s.o0[i] = 0.f; s.o1[i] = 0.f; }
    s.m = -INFINITY; s.l = 0.f; }
DEV s16x4 tr_read(LDSP p) { return __builtin_bit_cast(s16x4, __builtin_amdgcn_ds_read_tr16_b64_v4i16((LDS s16x4*)p)); }

DEV void flash_stage(const u32x4 (&kch)[4], const u32x4 (&vch)[4], LDSP vl, int lane) {
    const int c = lane & 7, row = lane >> 3; const int wo = (c >> 2) * 2048 + row * 64 + (c & 3) * 16;
#pragma unroll
    for (int i = 0; i < 4; ++i) { const int r = row + 8 * i; *(LDS u32x4*)(vl + 4096 + r * 128 + ((c ^ ((r >> 1) & 7)) << 4)) = kch[i]; *(LDS u32x4*)(vl + wo + i * 512) = vch[i]; }
}
DEV void flash_tile(Flash& st, const bf16x8 (&qf)[4], LDSP vl, int rl, int rh, int lane) {
    const int hl = lane >> 5, l31 = lane & 31;
    asm volatile("s_waitcnt lgkmcnt(0)" ::: "memory");
    f32x16 s;
#pragma unroll
    for (int i = 0; i < 16; ++i) s[i] = 0.f;
#pragma unroll
    for (int ks = 0; ks < 4; ++ks) { const bf16x8 kf = *(const LDS bf16x8*)(vl + 4096 + l31 * 128 + (((2 * ks + hl) ^ ((l31 >> 1) & 7)) << 4)); s = MFMA32(kf, qf[ks], s); }
    float mx = -INFINITY;
    const bool lfull = (rl <= 0) && (rh >= 27), lnone = (rh < 0) || (rl > 27) || (rh < rl);
    bool lane_off = false;
    const bool interior = __all(lfull || lnone);
    if (__builtin_expect(interior, 1)) {
#pragma unroll
        for (int i = 0; i < 16; ++i) mx = fmaxf(mx, s[i]);
        lane_off = !lfull; mx = lane_off ? -INFINITY : mx;
    } else {
#pragma unroll
        for (int i = 0; i < 16; ++i) { const int ci = (i & 3) + 8 * (i >> 2); const bool ok = (ci >= rl) && (ci <= rh); mx = fmaxf(mx, ok ? s[i] : -INFINITY); }
    }
    mx = xhalf_max(mx);
    float rs = 0.f;
    const bool grow = mx > st.m + 8.0f;
    const bool moved = __any(grow);
    const float mnew = grow ? mx : st.m, ms = (mnew == -INFINITY) ? 0.f : mnew;
    const float alpha = fexp2(st.m - ms);
    const float msub = lane_off ? INFINITY : ms;
    float pe[16];
#pragma unroll
    for (int i = 0; i < 16; ++i) pe[i] = fexp2(s[i] - msub);
    if (__builtin_expect(!interior, 0)) {
#pragma unroll
        for (int i = 0; i < 16; ++i) { const int ci = (i & 3) + 8 * (i >> 2); const bool ok = (ci >= rl) && (ci <= rh); pe[i] = ok ? pe[i] : 0.f; }
    }
#pragma unroll
    for (int i = 0; i < 16; ++i) rs += pe[i];
    st.l = st.l * alpha + rs; st.m = mnew;
    if (__builtin_expect(moved, 0)) {
#pragma unroll
        for (int i = 0; i < 16; ++i) { st.o0[i] *= alpha; st.o1[i] *= alpha; }
    }
    unsigned pk[8];
#pragma unroll
    for (int j = 0; j < 8; ++j) pk[j] = cvt_pk(pe[2 * j], pe[2 * j + 1]);
    asm volatile("s_waitcnt lgkmcnt(0)" ::: "memory");
    const int rb = (hl * 4 + ((lane & 15) >> 2)) * 64 + ((lane >> 4) & 1) * 32 + (lane & 3) * 8;
#pragma unroll
    for (int s2 = 0; s2 < 2; ++s2) {
        u32x4 pw; pw.x = pk[4 * s2]; pw.y = pk[4 * s2 + 1]; pw.z = pk[4 * s2 + 2]; pw.w = pk[4 * s2 + 3];
        const bf16x8 pf = __builtin_bit_cast(bf16x8, pw);
        { const s16x4 v0 = tr_read(vl + (16 * s2) * 64 + rb), v1 = tr_read(vl + (16 * s2 + 8) * 64 + rb);
          const bf16x8 vf = __builtin_shufflevector(v0, v1, 0, 1, 2, 3, 4, 5, 6, 7); st.o0 = MFMA32(vf, pf, st.o0); }
        { const s16x4 v0 = tr_read(vl + 2048 + (16 * s2) * 64 + rb), v1 = tr_read(vl + 2048 + (16 * s2 + 8) * 64 + rb);
          const bf16x8 vf = __builtin_shufflevector(v0, v1, 0, 1, 2, 3, 4, 5, 6, 7); st.o1 = MFMA32(vf, pf, st.o1); }
    }
    asm volatile("s_waitcnt lgkmcnt(0)" ::: "memory");
}
DEV bool tile_need(int kt, int lo, int hi, unsigned selmask) { const int kb = kt * 32; const int hie = ((selmask >> (kt >> 1)) & 1u) ? hi : -1; return (hie >= kb) && (lo <= kb + 31) && (hie >= lo); }
#define FR_NEXT(k) do { ++(k); while ((k) < kt1 && !__any(tile_need((k), lo, hi, selmask))) ++(k); } while (0)
#define FR_LOAD(KR, VR, k) do { _Pragma("unroll") for (int i_ = 0; i_ < 4; ++i_) { KR[i_] = *(const u32x4*)(kp + (size_t)((k) * 32 + 8 * i_) * stride); VR[i_] = *(const u32x4*)(vp + (size_t)((k) * 32 + 8 * i_) * stride); } } while (0)
DEV void flash_range(Flash& st, const bf16x8 (&qf)[4], const bf16_t* kbase, const bf16_t* vbase, int stride, int kt0, int kt1, int lo, int hi, unsigned selmask, LDSP vl, int lane) {
    const int hl = lane >> 5;
    const bf16_t* kp = kbase + (size_t)(lane >> 3) * stride + (lane & 7) * 8;
    const bf16_t* vp = vbase + (size_t)(lane >> 3) * stride + (lane & 7) * 8;
    int ta = kt0 - 1; FR_NEXT(ta);
    if (ta >= kt1) return;
    u32x4 kA[4], vA[4], kB[4], vB[4];
    FR_LOAD(kA, vA, ta);
    int tb = ta; FR_NEXT(tb);
    if (tb < kt1) FR_LOAD(kB, vB, tb);
    int cur = 0;
    flash_stage(kA, vA, vl, lane);
    int tc = tb; if (tb < kt1) { FR_NEXT(tc); if (tc < kt1) FR_LOAD(kA, vA, tc); }
    for (;;) {
        { const int kb = ta * 32; const int hie = ((selmask >> (ta >> 1)) & 1u) ? hi : -1; flash_tile(st, qf, vl + cur, lo - kb - 4 * hl, hie - kb - 4 * hl, lane); }
        if (tb >= kt1) break;
        cur ^= 8192; flash_stage(kB, vB, vl + cur, lane);
        ta = tb; tb = tc; if (tc < kt1) { FR_NEXT(tc); if (tc < kt1) FR_LOAD(kB, vB, tc); }
        { const int kb = ta * 32; const int hie = ((selmask >> (ta >> 1)) & 1u) ? hi : -1; flash_tile(st, qf, vl + cur, lo - kb - 4 * hl, hie - kb - 4 * hl, lane); }
        if (tb >= kt1) break;
        cur ^= 8192; flash_stage(kA, vA, vl + cur, lane);
        ta = tb; tb = tc; if (tc < kt1) { FR_NEXT(tc); if (tc < kt1) FR_LOAD(kA, vA, tc); }
    }
}
#undef FR_NEXT
#undef FR_LOAD
DEV float flash_final(Flash& st) { const float lt = xhalf_sum(st.l); const float inv = lt > 0.f ? 1.f / lt : 0.f;
#pragma unroll
    for (int i = 0; i < 16; ++i) { st.o0[i] *= inv; st.o1[i] *= inv; }
    return lt; }
DEV void store_o(bf16_t* dst  , const f32x16& o0, const f32x16& o1, int hl) {
#pragma unroll
    for (int g = 0; g < 4; ++g) { u32x2 w; w.x = cvt_pk(o0[4 * g], o0[4 * g + 1]); w.y = cvt_pk(o0[4 * g + 2], o0[4 * g + 3]); *(u32x2*)(dst + 8 * g + 4 * hl) = w;
        u32x2 z; z.x = cvt_pk(o1[4 * g], o1[4 * g + 1]); z.y = cvt_pk(o1[4 * g + 2], o1[4 * g + 3]); *(u32x2*)(dst + 32 + 8 * g + 4 * hl) = z; }
}
DEV unsigned wave_pull(unsigned* ctr, int lane) { unsigned v = 0; if (lane == 0) v = __hip_atomic_fetch_add(ctr, 1u, __ATOMIC_RELAXED, __HIP_MEMORY_SCOPE_AGENT); return (unsigned)__builtin_amdgcn_readfirstlane((int)v); }

DEV void dilated_task(const Params& p, int id, LDSP vl, int lane) {
    unsigned char* ws = p.ws; const int l31 = lane & 31, hl = lane >> 5;
    const int j = id & 63, pat = (id >> 6) % 3, bh = id / 192;
    int dil, r, qb;
    if (pat == 0) { dil = 1; r = 0; qb = j; } else if (pat == 1) { dil = 4; r = j >> 4; qb = j & 15; } else { dil = 16; r = j >> 2; qb = j & 3; }
    const bf16_t* Q = (const bf16_t*)(ws + OFF_QA) + (size_t)bh * 2048 * 64 + r * 64;
    const bf16_t* K = (const bf16_t*)(ws + OFF_KA) + (size_t)bh * 2048 * 64 + r * 64;
    const bf16_t* V = (const bf16_t*)(ws + OFF_VA) + (size_t)bh * 2048 * 64 + r * 64;
    const int stride = dil * 64, mq = qb * 32 + l31;
    bf16x8 qf[4];
#pragma unroll
    for (int ks = 0; ks < 4; ++ks) qf[ks] = *(const bf16x8*)(Q + (size_t)mq * stride + ks * 16 + hl * 8);
    Flash st; flash_init(st);
    flash_range(st, qf, K, V, stride, qb >= 4 ? qb - 4 : 0, qb + 1, mq >= 128 ? mq - 128 : 0, mq, 0xffffffffu, vl, lane);
    const float lt = flash_final(st);
    const int b = bh >> 3, h = bh & 7, tok = b * 2048 + mq * dil + r;
    store_o((bf16_t*)(ws + OFF_OP) + ((size_t)pat * T_TOK + tok) * 512 + h * 64, st.o0, st.o1, hl);
    if (hl == 0) __hip_atomic_store((float*)(ws + OFF_LSE) + ((size_t)pat * T_TOK + tok) * 8 + h, st.m + __builtin_log2f(lt), __ATOMIC_RELAXED, __HIP_MEMORY_SCOPE_AGENT);
}

DEV void dilated_pair(const Params& p, int id, LDSP vl, int lane) {
    unsigned char* ws = p.ws; const int l31 = lane & 31, hl = lane >> 5;
    const int j = id & 31, pat = (id >> 5) % 3, bh = id / 96;
    int dil, r, qb;
    if (pat == 0) { dil = 1; r = 0; qb = 2 * j; } else if (pat == 1) { dil = 4; r = j >> 3; qb = 2 * (j & 7); } else { dil = 16; r = j >> 1; qb = 2 * (j & 1); }
    const bf16_t* Q = (const bf16_t*)(ws + OFF_QA) + (size_t)bh * 2048 * 64 + r * 64;
    const bf16_t* K = (const bf16_t*)(ws + OFF_KA) + (size_t)bh * 2048 * 64 + r * 64;
    const bf16_t* V = (const bf16_t*)(ws + OFF_VA) + (size_t)bh * 2048 * 64 + r * 64;
    const int stride = dil * 64, mqA = qb * 32 + l31, mqB = mqA + 32;
    bf16x8 qfA[4], qfB[4];
#pragma unroll
    for (int ks = 0; ks < 4; ++ks) { qfA[ks] = *(const bf16x8*)(Q + (size_t)mqA * stride + ks * 16 + hl * 8); qfB[ks] = *(const bf16x8*)(Q + (size_t)mqB * stride + ks * 16 + hl * 8); }
    Flash sA, sB; flash_init(sA); flash_init(sB);
    const int loA = mqA >= 128 ? mqA - 128 : 0, loB = mqB >= 128 ? mqB - 128 : 0;
    const int kt1 = qb + 2;
    int ta = qb >= 4 ? qb - 4 : 0;
    const bf16_t* kp = K + (size_t)(lane >> 3) * stride + (lane & 7) * 8;
    const bf16_t* vp = V + (size_t)(lane >> 3) * stride + (lane & 7) * 8;
#define DP_LOAD(KR, VR, k) do { _Pragma("unroll") for (int i_ = 0; i_ < 4; ++i_) { KR[i_] = *(const u32x4*)(kp + (size_t)((k) * 32 + 8 * i_) * stride); VR[i_] = *(const u32x4*)(vp + (size_t)((k) * 32 + 8 * i_) * stride); } } while (0)
#define DP_TILE(kt, buf) do { const int kb_ = (kt) * 32; \
        if ((kt) <= qb) flash_tile(sA, qfA, (buf), loA - kb_ - 4 * hl, mqA - kb_ - 4 * hl, lane); \
        if ((kt) >= qb - 3) flash_tile(sB, qfB, (buf), loB - kb_ - 4 * hl, mqB - kb_ - 4 * hl, lane); } while (0)
    u32x4 kA[4], vA[4], kB[4], vB[4];
    DP_LOAD(kA, vA, ta);
    DP_LOAD(kB, vB, ta + 1);
    int cur = 0;
    flash_stage(kA, vA, vl, lane);
    if (ta + 2 < kt1) DP_LOAD(kA, vA, ta + 2);
    for (;;) {
        DP_TILE(ta, vl + cur);
        if (ta + 1 >= kt1) break;
        cur ^= 8192; flash_stage(kB, vB, vl + cur, lane);
        ++ta; if (ta + 2 < kt1) DP_LOAD(kB, vB, ta + 2);
        DP_TILE(ta, vl + cur);
        if (ta + 1 >= kt1) break;
        cur ^= 8192; flash_stage(kA, vA, vl + cur, lane);
        ++ta; if (ta + 2 < kt1) DP_LOAD(kA, vA, ta + 2);
    }
#undef DP_LOAD
#undef DP_TILE
    const int b = bh >> 3, h = bh & 7;
    { const float lt = flash_final(sA); const int tok = b * 2048 + mqA * dil + r;
      store_o((bf16_t*)(ws + OFF_OP) + ((size_t)pat * T_TOK + tok) * 512 + h * 64, sA.o0, sA.o1, hl);
      if (hl == 0) __hip_atomic_store((float*)(ws + OFF_LSE) + ((size_t)pat * T_TOK + tok) * 8 + h, sA.m + __builtin_log2f(lt), __ATOMIC_RELAXED, __HIP_MEMORY_SCOPE_AGENT); }
    { const float lt = flash_final(sB); const int tok = b * 2048 + mqB * dil + r;
      store_o((bf16_t*)(ws + OFF_OP) + ((size_t)pat * T_TOK + tok) * 512 + h * 64, sB.o0, sB.o1, hl);
      if (hl == 0) __hip_atomic_store((float*)(ws + OFF_LSE) + ((size_t)pat * T_TOK + tok) * 8 + h, sB.m + __builtin_log2f(lt), __ATOMIC_RELAXED, __HIP_MEMORY_SCOPE_AGENT); }
}

DEV void merge_tokens(const Params& p, int lane, int wid) {
    unsigned char* ws = p.ws; const bf16_t* OP = (const bf16_t*)(ws + OFF_OP); const float* LSE = (const float*)(ws + OFF_LSE); bf16_t* MIX = (bf16_t*)(ws + OFF_R1);
    const int h = lane >> 3, d0 = (lane & 7) * 8;
    for (int tok = blockIdx.x * 8 + wid; tok < T_TOK; tok += 2048) {
        float l0 = LSE[(size_t)tok * 8 + h], l1 = LSE[((size_t)T_TOK + tok) * 8 + h], l2 = LSE[((size_t)2 * T_TOK + tok) * 8 + h];
        const float mx = fmaxf(l0, fmaxf(l1, l2)); l0 = fexp2(l0 - mx); l1 = fexp2(l1 - mx); l2 = fexp2(l2 - mx); const float inv = 1.f / (l0 + l1 + l2); l0 *= inv; l1 *= inv; l2 *= inv;
        const u32x4 a = *(const u32x4*)(OP + (size_t)tok * 512 + h * 64 + d0), b = *(const u32x4*)(OP + ((size_t)T_TOK + tok) * 512 + h * 64 + d0), c = *(const u32x4*)(OP + ((size_t)2 * T_TOK + tok) * 512 + h * 64 + d0);
        u32x4 w;
#pragma unroll
        for (int i = 0; i < 4; ++i) { const float lo = l0 * bf_lo(a[i]) + l1 * bf_lo(b[i]) + l2 * bf_lo(c[i]), hi = l0 * bf_hi(a[i]) + l1 * bf_hi(b[i]) + l2 * bf_hi(c[i]); w[i] = cvt_pk(lo, hi); }
        *(u32x4*)(MIX + (size_t)tok * 1024 + h * 64 + d0) = w;
    }
}

DEV void nsa_sel_task(const Params& p, int qb, int bg, int lane) {
    unsigned char* ws = p.ws; const int l31 = lane & 31, hl = lane >> 5;
    const int b = bg >> 1, g = bg & 1, t0 = qb * 32, t = t0 + l31, tok = b * 2048 + t;
    const bf16_t* KC = (const bf16_t*)(ws + OFF_KC) + (size_t)bg * 128 * 64; const bf16_t* VC = (const bf16_t*)(ws + OFF_VC) + (size_t)bg * 128 * 64;
    const bf16_t* KS = (const bf16_t*)(ws + OFF_KV6 + 2 * 16 * MB) + (size_t)bg * 2048 * 64; const bf16_t* VS = (const bf16_t*)(ws + OFF_KV6 + 3 * 16 * MB) + (size_t)bg * 2048 * 64;
    const bf16_t* KW = (const bf16_t*)(ws + OFF_KV6 + 4 * 16 * MB) + (size_t)bg * 2048 * 64; const bf16_t* VW = (const bf16_t*)(ws + OFF_KV6 + 5 * 16 * MB) + (size_t)bg * 2048 * 64;
    const bf16_t* QBp = (const bf16_t*)(ws + OFF_QB) + ((size_t)(b * 8 + g * 4) * 2048 + t) * 64 + hl * 8;
    const int cmax = (t >= 31) ? (((t - 31) >> 4) < 126 ? ((t - 31) >> 4) : 126) : -1;
    f32x16 ps[4];
#pragma unroll
    for (int ct = 0; ct < 4; ++ct)
#pragma unroll
        for (int i = 0; i < 16; ++i) ps[ct][i] = 0.f;
#pragma unroll 1
    for (int r = 0; r < 4; ++r) {
        bf16x8 qf[4];
#pragma unroll
        for (int ks = 0; ks < 4; ++ks) qf[ks] = *(const bf16x8*)(QBp + (size_t)r * 2048 * 64 + ks * 16);
        float mx = -INFINITY, sum = 0.f;
#pragma unroll 1
        for (int ct = 0; ct < 4; ++ct) {
            f32x16 sc;
#pragma unroll
            for (int i = 0; i < 16; ++i) sc[i] = 0.f;
#pragma unroll
            for (int ks = 0; ks < 4; ++ks) { const bf16x8 kf = *(const bf16x8*)(KC + (size_t)(ct * 32 + l31) * 64 + ks * 16 + hl * 8); sc = MFMA32(kf, qf[ks], sc); }
            float tm = -INFINITY;
#pragma unroll
            for (int i = 0; i < 16; ++i) { const int c = ct * 32 + (i & 3) + 8 * (i >> 2) + 4 * hl; sc[i] = (c <= cmax) ? sc[i] : -INFINITY; tm = fmaxf(tm, sc[i]); }
            const float mn = fmaxf(mx, tm), ms = (mn == -INFINITY) ? 0.f : mn;
            float rs = 0.f;
#pragma unroll
            for (int i = 0; i < 16; ++i) rs += fexp2(sc[i] - ms);
            sum = sum * fexp2(mx - ms) + rs; mx = mn;
        }
        { const float mo = __shfl_xor(mx, 32), so = __shfl_xor(sum, 32); const float mn = fmaxf(mx, mo), ms = (mn == -INFINITY) ? 0.f : mn;
          sum = sum * fexp2(mx - ms) + so * fexp2(mo - ms); mx = ms; }
        const float inv = sum > 0.f ? 1.f / sum : 0.f;
#pragma unroll
        for (int ct = 0; ct < 4; ++ct) {
            f32x16 sc;
#pragma unroll
            for (int i = 0; i < 16; ++i) sc[i] = 0.f;
#pragma unroll
            for (int ks = 0; ks < 4; ++ks) { const bf16x8 kf = *(const bf16x8*)(KC + (size_t)(ct * 32 + l31) * 64 + ks * 16 + hl * 8); sc = MFMA32(kf, qf[ks], sc); }
#pragma unroll
            for (int i = 0; i < 16; ++i) { const int c = ct * 32 + (i & 3) + 8 * (i >> 2) + 4 * hl; const float e = (c <= cmax) ? fexp2(sc[i] - mx) * inv : 0.f; ps[ct][i] += e; }
        }
    }
    float ie[16], io[16];
    {
        float A[16], Tp[16];
#pragma unroll
        for (int ct = 0; ct < 4; ++ct)
#pragma unroll
            for (int gq = 0; gq < 4; ++gq) { const int jj = ct * 4 + gq; const float p3 = 0.5f * ps[ct][4 * gq + 3]; A[jj] = ps[ct][4 * gq] + ps[ct][4 * gq + 1] + ps[ct][4 * gq + 2] + p3; Tp[jj] = __shfl_xor(p3, 32); }
#pragma unroll
        for (int jj = 0; jj < 16; ++jj) { const float prev = (jj > 0) ? Tp[jj > 0 ? jj - 1 : 0] : 0.f; const float own = A[jj] + (hl ? Tp[jj] : prev); const float oth = __shfl_xor(own, 32);
            ie[jj] = hl ? oth : own; io[jj] = hl ? own : oth; }
    }
    const int blk = t0 >> 6;
    unsigned sel = 1u | (1u << blk) | (blk > 0 ? (1u << (blk - 1)) : 0u);
    {
        const int nforced = blk >= 2 ? 3 : blk + 1, nsel = 8 - nforced, ncand = blk - 2;
        if (ncand > 0) {
            if (ncand <= nsel) sel |= ((1u << (blk - 1)) - 2u);
            else {
#pragma unroll
                for (int jj = 0; jj < 16; ++jj) { const int je = 2 * jj, jo = 2 * jj + 1; ie[jj] = (je >= 1 && je <= blk - 2) ? ie[jj] : -1.f; io[jj] = (jo >= 1 && jo <= blk - 2) ? io[jj] : -1.f; }
                unsigned bits = 0u;
#pragma unroll
                for (int jj = 0; jj < 16; ++jj) {
                    const float cj = hl ? io[jj] : ie[jj]; int cnt = 0;
#pragma unroll
                    for (int j2 = 0; j2 < 16; ++j2) {
                        const bool lte = (j2 < jj) || (j2 == jj && hl);
                        const bool lto = (j2 < jj);
                        cnt += ((ie[j2] > cj) || (ie[j2] == cj && lte)) ? 1 : 0;
                        cnt += ((io[j2] > cj) || (io[j2] == cj && lto)) ? 1 : 0;
                    }
                    if (cj >= 0.f && cnt < nsel) bits |= (1u << (2 * jj)) << hl;
                }
                bits |= (unsigned)__shfl_xor((int)bits, 32);
                sel |= bits;
            }
        }
    }
    if (hl == 0) ((unsigned*)(ws + OFF_SEL))[(size_t)bg * 2048 + t] = sel;
}

DEV void nsa_head_task(const Params& p, int qb, int bg, int r, LDSP vl, int lane) {
    unsigned char* ws = p.ws; const int l31 = lane & 31, hl = lane >> 5;
    const int b = bg >> 1, g = bg & 1, t0 = qb * 32, t = t0 + l31, tok = b * 2048 + t;
    const bf16_t* KC = (const bf16_t*)(ws + OFF_KC) + (size_t)bg * 128 * 64; const bf16_t* VC = (const bf16_t*)(ws + OFF_VC) + (size_t)bg * 128 * 64;
    const bf16_t* KS = (const bf16_t*)(ws + OFF_KV6 + 2 * 16 * MB) + (size_t)bg * 2048 * 64; const bf16_t* VS = (const bf16_t*)(ws + OFF_KV6 + 3 * 16 * MB) + (size_t)bg * 2048 * 64;
    const bf16_t* KW = (const bf16_t*)(ws + OFF_KV6 + 4 * 16 * MB) + (size_t)bg * 2048 * 64; const bf16_t* VW = (const bf16_t*)(ws + OFF_KV6 + 5 * 16 * MB) + (size_t)bg * 2048 * 64;
    const bf16_t* QBp = (const bf16_t*)(ws + OFF_QB) + ((size_t)(b * 8 + g * 4 + r) * 2048 + t) * 64 + hl * 8;
    const int cmax = (t >= 31) ? (((t - 31) >> 4) < 126 ? ((t - 31) >> 4) : 126) : -1;
    const unsigned sel = ((const unsigned*)(ws + OFF_SEL))[(size_t)bg * 2048 + t];
    const float* GT = (const float*)(ws + OFF_GATE) + (size_t)tok * 24 + (g * 4 + r) * 3;
    bf16_t* MIX = (bf16_t*)(ws + OFF_R1) + (size_t)tok * 1024 + 512 + (g * 4 + r) * 64;
    const int wlo = t >= 511 ? t - 511 : 0, wk0 = (t0 >> 5) >= 16 ? (t0 >> 5) - 16 : 0, kend = (t0 >> 5) + 1;
    bf16x8 qf[4];
#pragma unroll
    for (int ks = 0; ks < 4; ++ks) qf[ks] = *(const bf16x8*)(QBp + ks * 16);
    const float g0 = GT[0], g1 = GT[1], g2 = GT[2];
    f32x16 t0a, t1a;
    { Flash st; flash_init(st); flash_range(st, qf, KC, VC, 64, 0, 4, 0, cmax, 0xffffffffu, vl, lane); flash_final(st);
#pragma unroll
      for (int i = 0; i < 16; ++i) { t0a[i] = g0 * st.o0[i]; t1a[i] = g0 * st.o1[i]; } }
    { Flash st; flash_init(st); flash_range(st, qf, KS, VS, 64, 0, kend, 0, t, sel, vl, lane); flash_final(st);
#pragma unroll
      for (int i = 0; i < 16; ++i) { t0a[i] += g1 * st.o0[i]; t1a[i] += g1 * st.o1[i]; } }
    { Flash st; flash_init(st); flash_range(st, qf, KW, VW, 64, wk0, kend, wlo, t, 0xffffffffu, vl, lane); flash_final(st);
#pragma unroll
      for (int i = 0; i < 16; ++i) { t0a[i] += g2 * st.o0[i]; t1a[i] += g2 * st.o1[i]; } }
    store_o(MIX, t0a, t1a, hl);
}

DEV void wg_sync() { asm volatile("s_waitcnt lgkmcnt(0)" ::: "memory"); __builtin_amdgcn_s_barrier(); asm volatile("" ::: "memory"); }
DEV void coop_branch(Flash& st, const bf16x8 (&qf)[4], const bf16_t* kbase, const bf16_t* vbase, int j0, int j1, unsigned blockmask, int lo, int hi, unsigned selmask, LDSP sb, int tid, int lane) {
    const int hl = lane >> 5;
    const int sh = tid >> 8, lt = tid & 255, row = lt >> 3, c = lt & 7;
    const bf16_t* src = (sh ? vbase : kbase) + (size_t)row * 64 + c * 8;
    const int dsto = sh ? ((c >> 2) * 2048 + row * 64 + (c & 3) * 16) : (4096 + row * 128 + ((c ^ ((row >> 1) & 7)) << 4));
#define CB_NEXT(k) do { ++(k); while ((k) < j1 && !((blockmask >> (k)) & 1u)) ++(k); } while (0)
    int ja = j0 - 1; CB_NEXT(ja);
    if (ja >= j1) return;
    u32x4 r0 = *(const u32x4*)(src + (size_t)ja * 64 * 64), r1 = *(const u32x4*)(src + (size_t)(ja * 64 + 32) * 64);
    int jb = ja; CB_NEXT(jb);
    *(LDS u32x4*)(sb + dsto) = r0; *(LDS u32x4*)(sb + 8192 + dsto) = r1;
    if (jb < j1) { r0 = *(const u32x4*)(src + (size_t)jb * 64 * 64); r1 = *(const u32x4*)(src + (size_t)(jb * 64 + 32) * 64); }
    wg_sync();
    int cur = 0;
    for (;;) {
        const int hie = ((selmask >> ja) & 1u) ? hi : -1;
#pragma unroll
        for (int h2 = 0; h2 < 2; ++h2) { const int kb = ja * 64 + h2 * 32;
            if (__any((hie >= kb) && (lo <= kb + 31) && (hie >= lo))) flash_tile(st, qf, sb + cur + h2 * 8192, lo - kb - 4 * hl, hie - kb - 4 * hl, lane); }
        if (jb >= j1) break;
        *(LDS u32x4*)(sb + (cur ^ 16384) + dsto) = r0; *(LDS u32x4*)(sb + (cur ^ 16384) + 8192 + dsto) = r1;
        int jc = jb; CB_NEXT(jc);
        if (jc < j1) { r0 = *(const u32x4*)(src + (size_t)jc * 64 * 64); r1 = *(const u32x4*)(src + (size_t)(jc * 64 + 32) * 64); }
        wg_sync();
        cur ^= 16384; ja = jb; jb = jc;
    }
    wg_sync();
#undef CB_NEXT
}
DEV void nsa_wg_task(const Params& p, int qq, int bg, LDSP lds, int tid, int lane, int wid) {
    unsigned char* ws = p.ws; const int l31 = lane & 31, hl = lane >> 5, r = wid & 3, half = wid >> 2;
    const int b = bg >> 1, g = bg & 1, t0 = qq * 64 + 32 * half, t = t0 + l31, tok = b * 2048 + t;
    const bf16_t* KC = (const bf16_t*)(ws + OFF_KC) + (size_t)bg * 128 * 64; const bf16_t* VC = (const bf16_t*)(ws + OFF_VC) + (size_t)bg * 128 * 64;
    const bf16_t* KS = (const bf16_t*)(ws + OFF_KV6 + 2 * 16 * MB) + (size_t)bg * 2048 * 64; const bf16_t* VS = (const bf16_t*)(ws + OFF_KV6 + 3 * 16 * MB) + (size_t)bg * 2048 * 64;
    const bf16_t* KW = (const bf16_t*)(ws + OFF_KV6 + 4 * 16 * MB) + (size_t)bg * 2048 * 64; const bf16_t* VW = (const bf16_t*)(ws + OFF_KV6 + 5 * 16 * MB) + (size_t)bg * 2048 * 64;
    const bf16_t* QBp = (const bf16_t*)(ws + OFF_QB) + ((size_t)(b * 8 + g * 4 + r) * 2048 + t) * 64 + hl * 8;
    const int cmax = (t >= 31) ? (((t - 31) >> 4) < 126 ? ((t - 31) >> 4) : 126) : -1;
    const unsigned sel = ((const unsigned*)(ws + OFF_SEL))[(size_t)bg * 2048 + t];
    unsigned um = 0u;
#pragma unroll
    for (int j = 0; j < 32; ++j) um |= __any((sel >> j) & 1u) ? (1u << j) : 0u;
    LDS unsigned* xw = (LDS unsigned*)(lds + 32768);
    if (lane == 0) xw[wid] = um;
    wg_sync();
    um = xw[0] | xw[4];
    const float* GT = (const float*)(ws + OFF_GATE) + (size_t)tok * 24 + (g * 4 + r) * 3;
    bf16_t* MIX = (bf16_t*)(ws + OFF_R1) + (size_t)tok * 1024 + 512 + (g * 4 + r) * 64;
    const int wlo = t >= 511 ? t - 511 : 0, jend = qq + 1, wj0 = qq >= 8 ? qq - 8 : 0;
    bf16x8 qf[4];
#pragma unroll
    for (int ks = 0; ks < 4; ++ks) qf[ks] = *(const bf16x8*)(QBp + ks * 16);
    const float g0 = GT[0], g1 = GT[1], g2 = GT[2];
    f32x16 t0a, t1a;
    { Flash st; flash_init(st); coop_branch(st, qf, KC, VC, 0, 2, 0xffffffffu, 0, cmax, 0xffffffffu, lds, tid, lane); flash_final(st);
#pragma unroll
      for (int i = 0; i < 16; ++i) { t0a[i] = g0 * st.o0[i]; t1a[i] = g0 * st.o1[i]; } }
    { Flash st; flash_init(st); coop_branch(st, qf, KS, VS, 0, jend, um, 0, t, sel, lds, tid, lane); flash_final(st);
#pragma unroll
      for (int i = 0; i < 16; ++i) { t0a[i] += g1 * st.o0[i]; t1a[i] += g1 * st.o1[i]; } }
    { Flash st; flash_init(st); coop_branch(st, qf, KW, VW, wj0, jend, 0xffffffffu, wlo, t, 0xffffffffu, lds, tid, lane); flash_final(st);
#pragma unroll
      for (int i = 0; i < 16; ++i) { t0a[i] += g2 * st.o0[i]; t1a[i] += g2 * st.o1[i]; } }
    store_o(MIX, t0a, t1a, hl);
}

DEV void router_wave(const Params& p, int tok0, int lane, int wid, LDSP lds) {
    unsigned char* ws = p.ws; const int l31 = lane & 31, hl = lane >> 5, tok = tok0 + l31;
    const bf16_t* xh = (const bf16_t*)(ws + OFF_X1B) + (size_t)tok * 1024 + hl * 8; const bf16_t* xl = (const bf16_t*)(ws + OFF_X1L) + (size_t)tok * 1024 + hl * 8;
    const bf16_t* WR = (const bf16_t*)(ws + OFF_WRT);
    const int r8 = lane >> 3, slot = lane & 7;
    unsigned wo[3];
#pragma unroll
    for (int i = 0; i < 3; ++i) { const int R = 24 * wid + 8 * i + r8; wo[i] = (unsigned)(R < 96 ? R : R + 32) * 1024u + (unsigned)((slot ^ ((R >> 1) & 7)) << 3); }
    const int dw = wid * 3072;
    const int fbo = l31 * 128, sw = (l31 >> 1) & 7;
    f32x16 acc[3];
#pragma unroll
    for (int a = 0; a < 3; ++a)
#pragma unroll
        for (int i = 0; i < 16; ++i) acc[a][i] = 0.f;
    float ss = 0.f;
    asm volatile("s_waitcnt lgkmcnt(0)" ::: "memory");
    __builtin_amdgcn_s_barrier();
    asm volatile("" ::: "memory");
#pragma unroll
    for (int i = 0; i < 3; ++i) GLDS16(WR + wo[i], dw + i * 1024);
    u32x4 aN[8];
#pragma unroll
    for (int ks = 0; ks < 4; ++ks) { aN[2 * ks] = *(const u32x4*)(xh + ks * 16); aN[2 * ks + 1] = *(const u32x4*)(xl + ks * 16); }
#pragma unroll 1
    for (int kt = 0; kt < 16; ++kt) {
        asm volatile("s_waitcnt vmcnt(0)" ::: "memory");
        __builtin_amdgcn_s_barrier();
        asm volatile("" ::: "memory");
        u32x4 aC[8];
#pragma unroll
        for (int i = 0; i < 8; ++i) aC[i] = aN[i];
        const int cur = (kt & 1) * 24576;
        if (kt + 1 < 16) { const int ko = (kt + 1) * 64;
#pragma unroll
            for (int ks = 0; ks < 4; ++ks) { aN[2 * ks] = *(const u32x4*)(xh + ko + ks * 16); aN[2 * ks + 1] = *(const u32x4*)(xl + ko + ks * 16); }
#pragma unroll
            for (int i = 0; i < 3; ++i) GLDS16(WR + (wo[i] + (unsigned)ko), (24576 - cur) + dw + i * 1024); }
#pragma unroll
        for (int ks = 0; ks < 4; ++ks) {
            const u32x4 ahu = aC[2 * ks], alu = aC[2 * ks + 1];
#pragma unroll
            for (int i = 0; i < 4; ++i) { const float a = bf_lo(ahu[i]) + bf_lo(alu[i]), c = bf_hi(ahu[i]) + bf_hi(alu[i]); ss += a * a + c * c; }
            const bf16x8 ah = __builtin_bit_cast(bf16x8, ahu), al = __builtin_bit_cast(bf16x8, alu);
            const int ch = ((2 * ks + hl) ^ sw) << 4;
#pragma unroll
            for (int gr = 0; gr < 3; ++gr) { const bf16x8 bh = *(const LDS bf16x8*)(lds + cur + gr * 4096 + fbo + ch), bl = *(const LDS bf16x8*)(lds + cur + 12288 + gr * 4096 + fbo + ch);
                acc[gr] = MFMA32(bh, ah, acc[gr]); acc[gr] = MFMA32(bh, al, acc[gr]); acc[gr] = MFMA32(bl, ah, acc[gr]); }
        }
    }
    ss += __shfl_xor(ss, 32);
    const float rstd = 1.0f / sqrtf(ss * (1.0f / 1024.0f) + EPSN);
    int gs = 0; float pg;
    { float lg[8], mx = -INFINITY;
#pragma unroll
      for (int i = 0; i < 8; ++i) { lg[i] = acc[0][i] * rstd + p.b_rg[i]; if (lg[i] > mx) { mx = lg[i]; gs = i; } }
      float z = 0.f;
#pragma unroll
      for (int i = 0; i < 8; ++i) z += __expf(lg[i] - mx);
      pg = 1.f / z; }
    { const int go = __shfl_xor(gs, 32); const float po = __shfl_xor(pg, 32); if (hl) { gs = go; pg = po; } }
    const int ci = gs >> 1;
    float el[8];
#pragma unroll
    for (int k = 0; k < 8; ++k) {
        const float h1 = ci == 0 ? acc[0][k] : ci == 1 ? acc[0][8 + k] : ci == 2 ? acc[1][k] : acc[1][8 + k];
        const float h0 = ci == 0 ? acc[0][8 + k] : ci == 1 ? acc[1][k] : ci == 2 ? acc[1][8 + k] : acc[2][k];
        el[k] = (hl ? h1 : h0) * rstd + p.b_re[gs * 8 + k];
    }
    if (hl == 1 - (gs & 1)) {
        int i1 = 0; float m1 = -INFINITY;
#pragma unroll
        for (int k = 0; k < 8; ++k) if (el[k] > m1) { m1 = el[k]; i1 = k; }
        int i2 = 0; float m2 = -INFINITY;
#pragma unroll
        for (int k = 0; k < 8; ++k) if (k != i1 && el[k] > m2) { m2 = el[k]; i2 = k; }
        const float e2 = __expf(m2 - m1), w1 = pg / (1.f + e2), w2 = pg * e2 / (1.f + e2);
        const int ex1 = gs * 8 + i1, ex2 = gs * 8 + i2;
        unsigned* cnt = (unsigned*)(ws + OFF_CNT); unsigned* LIST = (unsigned*)(ws + OFF_LIST);
        const unsigned p1 = __hip_atomic_fetch_add(cnt + ex1, 1u, __ATOMIC_RELAXED, __HIP_MEMORY_SCOPE_AGENT);
        const unsigned p2 = __hip_atomic_fetch_add(cnt + ex2, 1u, __ATOMIC_RELAXED, __HIP_MEMORY_SCOPE_AGENT);
        __hip_atomic_store(LIST + (size_t)ex1 * 65536 + p1, (unsigned)tok * 2u, __ATOMIC_RELAXED, __HIP_MEMORY_SCOPE_AGENT);
        __hip_atomic_store(LIST + (size_t)ex2 * 65536 + p2, (unsigned)tok * 2u + 1u, __ATOMIC_RELAXED, __HIP_MEMORY_SCOPE_AGENT);
        int* TE = (int*)(ws + OFF_TE); int* TP = (int*)(ws + OFF_TP); float* TW = (float*)(ws + OFF_TW);
        TE[tok * 2] = ex1; TE[tok * 2 + 1] = ex2; TP[tok * 2] = (int)p1; TP[tok * 2 + 1] = (int)p2; TW[tok * 2] = w1; TW[tok * 2 + 1] = w2;
        ((float*)(ws + OFF_RSTD2))[tok] = rstd;
    }
}

DEV void build_tb(const Params& p, LDS int* tb) {
    if (threadIdx.x == 0) { const unsigned* cnt = (const unsigned*)(p.ws + OFF_CNT); int a = 0;
        for (int e = 0; e < 64; ++e) { tb[e] = a; const int n = (int)((cnt[e] + 255u) >> 8); for (int t = 0; t < n; ++t) tb[128 + a + t] = e; a += n; }
        tb[64] = a; }
    __syncthreads();
}

extern __shared__ __attribute__((aligned(16))) unsigned char smem_raw[];
__global__ void __launch_bounds__(512, 2) hymba_fwd(Params p) {
    __shared__ uint4 xb_words;
    if (threadIdx.x == 0) xb_words = make_uint4(0u, 0u, 0u, 0u);
    __syncthreads();
    unsigned char* ws = p.ws;
    (void)xcd_barrier_post((unsigned*)(ws + OFF_BAR), (volatile LAS unsigned*)&xb_words);
#if DBG_XBAR
#define GRID_BAR() do { xcd_barrier((unsigned*)(p.ws + OFF_BAR), (volatile LAS unsigned*)&xb_words); xcd_barrier((unsigned*)(p.ws + OFF_BAR), (volatile LAS unsigned*)&xb_words); } while (0)
#else
#define GRID_BAR() xcd_barrier((unsigned*)(p.ws + OFF_BAR), (volatile LAS unsigned*)&xb_words)
#endif
    LDSP lds = (LDSP)smem_raw;
    const int bid = blockIdx.x, xcd = bid & 7, ci = bid >> 3;
#define PHASE_IDS const int tid = opaque((int)threadIdx.x), lane = tid & 63, wid = __builtin_amdgcn_readfirstlane(tid >> 6); LDSP vl = lds + wid * 16384; (void)lane; (void)vl;

#if SKEL < 2
    REPS(0) if (!SKEL) p0_prologue(p, lds);
    GRID_BAR();

    REPS(1) if (!SKEL) {
        const OrderXcd S{(const char*)(ws + OFF_R1), (const char*)(ws + OFF_WINT), (size_t)256 * 1024 * 2, (size_t)256 * 1024 * 2, 12, 12, xcd, ci};
        pg::gemm_phase<EpiInProj, OrderXcd, true, false>(lds, 1024, 1024, S, EpiInProj{ws});
    }
    GRID_BAR();

    REPS(20) if (!SKEL && bid < 64) {
        const int kv = bid & 1, mt = bid >> 1;
        { OrderOne S{}; S.u.a = (const char*)(ws + OFF_KV6 + (size_t)kv * 16 * MB) + (size_t)mt * 256 * 1024 * 2; S.u.b = (const char*)(ws + OFF_WC1T) + (size_t)kv * 256 * 2048 * 2; S.u.pm = mt; S.u.pn = 0; S.u.x0 = 0; S.u.x1 = 0; S.u.x2 = 0;
          pg::gemm_phase<EpiCmp1, OrderOne, false, false>(lds, 2048, 1024, S, EpiCmp1{ws, kv}); }
        asm volatile("s_waitcnt vmcnt(0)" ::: "memory");
        __syncthreads();
        { OrderOne S{}; S.u.a = (const char*)(ws + OFF_HID) + ((size_t)kv * 8192 + (size_t)mt * 256) * 256 * 2; S.u.b = (const char*)(ws + OFF_WC2T) + (size_t)kv * 256 * 256 * 2; S.u.pm = mt; S.u.pn = 0; S.u.x0 = 0; S.u.x1 = 0; S.u.x2 = 0;
          pg::gemm_phase<EpiCmp2, OrderOne, false, false>(lds, 256, 256, S, EpiCmp2{ws, kv}); }
    }
#if EN_DIL
    REPS(2) if (!SKEL) { PHASE_IDS
        unsigned* qbase = (unsigned*)(ws + OFF_QUEUE) + 512 * rep_;
        const int x0 = (int)xb_xcc_id() & 7;
        for (int dq = 0; dq < 8; ++dq) { const int x = (x0 + dq) & 7; unsigned* ctr = qbase + x * 16;
            for (;;) { const unsigned t = wave_pull(ctr, lane); if (t >= 3072u) break; dilated_pair(p, x * 3072 + (int)t, vl, opaque(lane)); } }
    }
#endif
    GRID_BAR();

    if (!SKEL) { PHASE_IDS
#if EN_DIL
    merge_tokens(p, lane, wid);
#else
    for (int tok = bid * 8 + wid; tok < T_TOK; tok += 2048) *(u32x4*)((bf16_t*)(ws + OFF_R1) + (size_t)tok * 1024 + lane * 8) = (u32x4){0u, 0u, 0u, 0u};
#endif
    }
    REPS(3) if (!SKEL) { PHASE_IDS
#if EN_NSA
        const int x0 = (int)xb_xcc_id() & 7;
        { unsigned* qbase = (unsigned*)(ws + OFF_QUEUE) + 384;
          for (int dq = 0; dq < 8; ++dq) { const int x = (x0 + dq) & 7; unsigned* ctr = qbase + x * 16;
            for (;;) { const unsigned t = wave_pull(ctr, lane); if (t >= 512u) break; nsa_sel_task(p, 63 - (int)(t & 63u), 8 * x + (int)(t >> 6), opaque(lane)); } } }
        GRID_BAR();
        { unsigned* qbase = (unsigned*)(ws + OFF_QUEUE) + 256 + 512 * rep_;
          LDS unsigned* tw = (LDS unsigned*)(lds + 32768 + 64);
          for (int dq = 0; dq < 8; ++dq) { const int x = (x0 + dq) & 7; unsigned* ctr = qbase + x * 16;
            for (;;) { if (tid == 0) tw[0] = __hip_atomic_fetch_add(ctr, 1u, __ATOMIC_RELAXED, __HIP_MEMORY_SCOPE_AGENT);
                wg_sync(); const unsigned t = tw[0]; wg_sync();
                if (t >= 256u) break;
                nsa_wg_task(p, 31 - (int)(t & 31u), 8 * x + (int)(t >> 5), lds, tid, opaque(lane), wid); } } }
#else
    for (int tok = bid * 8 + wid; tok < T_TOK; tok += 2048) *(u32x4*)((bf16_t*)(ws + OFF_R1) + (size_t)tok * 1024 + 512 + lane * 8) = (u32x4){0u, 0u, 0u, 0u};
#endif
    }
    GRID_BAR();

    REPS(4) if (!SKEL) {
        const OrderXcd S{(const char*)(ws + OFF_R1), (const char*)(ws + OFF_WOT), (size_t)256 * 1024 * 2, (size_t)256 * 1024 * 2, 4, 4, xcd, ci};
        pg::gemm_phase<EpiOut, OrderXcd, true, false>(lds, 1024, 1024, S, EpiOut{ws, p.x});
    }
    GRID_BAR();

#endif
    LDS int* tb = (LDS int*)(lds + LDS_TB); (void)tb;
#if EN_MOE && !SKEL
    { PHASE_IDS
    router_wave(p, (bid * 8 + wid) * 32, lane, wid, lds); }
    GRID_BAR();

    build_tb(p, tb);
    REPS(6) {
        const OrderMoe1 S{(const char*)(ws + OFF_X1B), (const char*)(ws + OFF_WGUT), (const unsigned*)(ws + OFF_LIST), (const unsigned*)(ws + OFF_CNT), (LDS const int*)tb, tb[64], bid};
#ifndef NO_P6
        pg::gemm_phase<EpiMoe1, OrderMoe1, true, true>(lds, 1024, 1024, S, EpiMoe1{ws});
#endif
    }
    GRID_BAR();

    REPS(7) {
        const OrderMoe2 S{(const char*)(ws + OFF_HE), (const char*)(ws + OFF_WDT), (LDS const int*)tb, tb[64], bid};
#ifndef NO_P7
        pg::gemm_phase<EpiMoe2, OrderMoe2, true, false>(lds, 256, 256, S, EpiMoe2{ws});
#endif
    }
    GRID_BAR();
#endif

    REPS(8) { PHASE_IDS
        const bf16_t* XB = (const bf16_t*)(ws + OFF_X1B); const bf16_t* Y = (const bf16_t*)(ws + OFF_Y);
        const int* TE = (const int*)(ws + OFF_TE); const int* TP = (const int*)(ws + OFF_TP); const float* TW = (const float*)(ws + OFF_TW);
        f32x4 gf[4];
#pragma unroll
        for (int i = 0; i < 4; ++i) gf[i] = *(const f32x4*)(p.norm_f_g + i * 256 + lane * 4);
        int tok = bid * 8 + wid;
        u32x2 te[2], tp[2]; f32x2 tw[2];
#pragma unroll
        for (int j = 0; j < 2; ++j) { const int t = tok + 2048 * j; te[j] = *(const u32x2*)(TE + t * 2); tp[j] = *(const u32x2*)(TP + t * 2); tw[j] = *(const f32x2*)(TW + t * 2); }
        for (; tok < T_TOK; tok += 4096) {
            u32x2 xa[2][4], ya[2][4], yb[2][4];
#pragma unroll
            for (int j = 0; j < 2; ++j) { const int t = tok + 2048 * j;
                const bf16_t* y0 = Y + (size_t)(tb[te[j].x] * 256 + (int)tp[j].x) * 1024; const bf16_t* y1 = Y + (size_t)(tb[te[j].y] * 256 + (int)tp[j].y) * 1024;
#pragma unroll
                for (int i = 0; i < 4; ++i) { const int c = i * 256 + lane * 4; xa[j][i] = *(const u32x2*)(XB + (size_t)t * 1024 + c); ya[j][i] = *(const u32x2*)(y0 + c); yb[j][i] = *(const u32x2*)(y1 + c); } }
            f32x2 twc[2] = {tw[0], tw[1]};
            { const int tn = tok + 4096 < T_TOK ? tok + 4096 : tok;
#pragma unroll
              for (int j = 0; j < 2; ++j) { const int t = tn + 2048 * j; te[j] = *(const u32x2*)(TE + t * 2); tp[j] = *(const u32x2*)(TP + t * 2); tw[j] = *(const f32x2*)(TW + t * 2); } }
#pragma unroll
            for (int j = 0; j < 2; ++j) { const int t = tok + 2048 * j; const float w0 = twc[j].x, w1 = twc[j].y;
                float v[16]; float ss = 0.f;
#pragma unroll
                for (int i = 0; i < 4; ++i) {
                    v[4 * i] = bf_lo(xa[j][i].x) + w0 * bf_lo(ya[j][i].x) + w1 * bf_lo(yb[j][i].x); v[4 * i + 1] = bf_hi(xa[j][i].x) + w0 * bf_hi(ya[j][i].x) + w1 * bf_hi(yb[j][i].x);
                    v[4 * i + 2] = bf_lo(xa[j][i].y) + w0 * bf_lo(ya[j][i].y) + w1 * bf_lo(yb[j][i].y); v[4 * i + 3] = bf_hi(xa[j][i].y) + w0 * bf_hi(ya[j][i].y) + w1 * bf_hi(yb[j][i].y);
                    ss += v[4 * i] * v[4 * i] + v[4 * i + 1] * v[4 * i + 1] + v[4 * i + 2] * v[4 * i + 2] + v[4 * i + 3] * v[4 * i + 3]; }
#pragma unroll
                for (int o = 32; o > 0; o >>= 1) ss += __shfl_xor(ss, o);
                const float rs = 1.0f / sqrtf(ss * (1.0f / 1024.0f) + EPSN);
#pragma unroll
                for (int i = 0; i < 4; ++i) { const int c = i * 256 + lane * 4;
                    f32x4 o; o[0] = v[4 * i] * rs * gf[i][0]; o[1] = v[4 * i + 1] * rs * gf[i][1]; o[2] = v[4 * i + 2] * rs * gf[i][2]; o[3] = v[4 * i + 3] * rs * gf[i][3];
                    *(f32x4*)(p.out + (size_t)t * 1024 + c) = o; } }
        }
    }
}

extern "C" void kernel_launch(void* const* d_in, const int* in_sizes, int n_in, void* d_out, int out_size, void* d_ws, size_t ws_size, hipStream_t stream) {
    static int grid = 0;
    if (grid == 0) {
        int dev = 0, cus = 0;
        if (hipGetDevice(&dev) != hipSuccess || hipDeviceGetAttribute(&cus, hipDeviceAttributeMultiprocessorCount, dev) != hipSuccess) { grid = -1; return; }
        if (hipFuncSetAttribute((const void*)hymba_fwd, hipFuncAttributeMaxDynamicSharedMemorySize, LDS_TOTAL) != hipSuccess) { grid = -1; return; }
        int per_cu = 0;
        (void)hipOccupancyMaxActiveBlocksPerMultiprocessor(&per_cu, (const void*)hymba_fwd, 512, LDS_TOTAL);
        (void)hipGetLastError();
        grid = cus < 256 ? cus : 256;
    }
    if (grid < 0) return;
    (void)hipMemsetAsync(d_ws, 0, CTL_ZERO, stream);
    Params p{};
    p.x = (const float*)d_in[0]; p.norm1_g = (const float*)d_in[1]; p.w_in = (const float*)d_in[2]; p.pe_kc = (const float*)d_in[3]; p.w_kc1 = (const float*)d_in[4]; p.w_kc2 = (const float*)d_in[5];
    p.pe_vc = (const float*)d_in[6]; p.w_vc1 = (const float*)d_in[7]; p.w_vc2 = (const float*)d_in[8]; p.w_o = (const float*)d_in[9]; p.norm2_g = (const float*)d_in[10];
    p.w_rg = (const float*)d_in[11]; p.b_rg = (const float*)d_in[12]; p.w_re = (const float*)d_in[13]; p.b_re = (const float*)d_in[14]; p.w_gate = (const float*)d_in[15]; p.w_up = (const float*)d_in[16]; p.w_down = (const float*)d_in[17]; p.norm_f_g = (const float*)d_in[18];
    p.out = (float*)d_out; p.ws = (unsigned char*)d_ws;
    hipLaunchKernelGGL(hymba_fwd, dim3(grid), dim3(512), LDS_TOTAL, stream, p);
}
```

```cpp
#include <hip/hip_runtime.h>
#include <stdint.h>
#include <math.h>

#ifndef EN_DIL
#define EN_DIL 1
#endif
#ifndef EN_NSA
#define EN_NSA 1
#endif
#ifndef EN_MOE
#define EN_MOE 1
#endif
#ifndef DBG_T1
#define DBG_T1 0
#endif
#ifndef DBG_T2
#define DBG_T2 0
#endif
#ifndef DBG_T3
#define DBG_T3 0
#endif
#ifndef DBG_T4
#define DBG_T4 0
#endif
#ifndef DBG_T5
#define DBG_T5 0
#endif
#ifndef DBG_T6
#define DBG_T6 0
#endif
#ifndef DBG_T8
#define DBG_T8 0
#endif
#ifndef GEMM_SAFE
#define GEMM_SAFE 0
#endif
#ifndef DBG_T9
#define DBG_T9 0
#endif
#ifndef DBG_TA
#define DBG_TA 0
#endif
#ifndef REP_PHASE
#define REP_PHASE -1
#endif
#define REPS(k) for (int rep_ = 0; rep_ < ((REP_PHASE == (k)) ? 2 : 1); ++rep_)
#ifndef DBG_LDSPOISON
#define DBG_LDSPOISON 0
#endif
#ifndef DBG_XBAR
#define DBG_XBAR 0
#endif
#ifndef SKEL
#define SKEL 0
#endif

#define DEV __device__ __forceinline__
#define LDS __attribute__((address_space(3)))
typedef LDS unsigned char* LDSP;
typedef unsigned short bf16_t;
typedef short bf16x8 __attribute__((ext_vector_type(8)));
typedef short s16x4 __attribute__((ext_vector_type(4)));
typedef float f32x16 __attribute__((ext_vector_type(16)));
typedef float f32x4 __attribute__((ext_vector_type(4)));
typedef unsigned u32x4 __attribute__((ext_vector_type(4)));
typedef unsigned u32x2 __attribute__((ext_vector_type(2)));
typedef float f32x2 __attribute__((ext_vector_type(2)));

#define MFMA32(a, b, c) __builtin_amdgcn_mfma_f32_32x32x16_bf16(a, b, c, 0, 0, 0)

constexpr int T_TOK = 65536, SEQ = 2048, DM = 1024;
constexpr int NPROJ = 2840, NPAD = 3072;
constexpr float SCQ = 0.125f * 1.4426950408889634f;
constexpr float EPSN = 1e-6f;

constexpr size_t MB = 1048576;
constexpr size_t OFF_BAR = 0, OFF_QUEUE = 28672, OFF_CNT = 20480, OFF_BIAS1 = 24576, CTL_ZERO = 32768;
constexpr size_t OFF_ROPEC = 1 * MB, OFF_ROPES = 1 * MB + 65536;
constexpr size_t OFF_SEL = 1 * MB + 131072;
constexpr size_t OFF_WINT = 2 * MB;
constexpr size_t OFF_WOT = OFF_WINT + (size_t)NPAD * 1024 * 2;
constexpr size_t OFF_WC1T = OFF_WOT + (size_t)1024 * 1024 * 2;
constexpr size_t OFF_WC2T = OFF_WC1T + (size_t)2 * 256 * 2048 * 2;
constexpr size_t OFF_WRT = OFF_WC2T + (size_t)2 * 256 * 256 * 2;
constexpr size_t OFF_WGUT = OFF_WRT + (size_t)2 * 128 * 1024 * 2;
constexpr size_t OFF_WDT = OFF_WGUT + (size_t)64 * 512 * 1024 * 2;
constexpr size_t OFF_LIST = OFF_WDT + (size_t)64 * 1024 * 256 * 2;
constexpr size_t OFF_TE = OFF_LIST + (size_t)64 * 65536 * 4;
constexpr size_t OFF_TP = OFF_TE + (size_t)T_TOK * 2 * 4;
constexpr size_t OFF_TW = OFF_TP + (size_t)T_TOK * 2 * 4;
constexpr size_t OFF_RSTD2 = OFF_TW + (size_t)T_TOK * 2 * 4;
constexpr size_t OFF_WEND = OFF_RSTD2 + (size_t)T_TOK * 4;
constexpr size_t OFF_R1 = 136 * MB;
constexpr size_t OFF_R2 = 264 * MB;
constexpr size_t OFF_QA = OFF_R2, OFF_KA = OFF_R2 + 64 * MB, OFF_VA = OFF_R2 + 128 * MB, OFF_QB = OFF_R2 + 192 * MB;
constexpr size_t OFF_KV6 = OFF_R2 + 256 * MB;
constexpr size_t OFF_GATE = OFF_R2 + 352 * MB;
constexpr size_t OFF_R3 = 622 * MB;
constexpr size_t OFF_OP = OFF_R3;
constexpr size_t OFF_LSE = OFF_R3 + 192 * MB;
constexpr size_t OFF_HID = OFF_R3 + 198 * MB;
constexpr size_t OFF_KC = OFF_R3 + 206 * MB;
constexpr size_t OFF_VC = OFF_R3 + 207 * MB;
constexpr size_t OFF_X1B = OFF_R2, OFF_X1L = OFF_R2 + 128 * MB;
constexpr size_t OFF_HE = OFF_R1;
constexpr size_t OFF_Y = OFF_R2 + 256 * MB;
static_assert(OFF_WEND <= OFF_R1, "weights region overflow");
static_assert(OFF_Y + (size_t)147456 * 1024 * 2 <= OFF_HID, "Y overlaps live data");

constexpr int LDS_GEMM = 131072;
constexpr int LDS_TB = LDS_GEMM;
constexpr int LDS_TOTAL = LDS_GEMM + 4096;

struct Params {
    const float* x; const float* norm1_g; const float* w_in; const float* pe_kc; const float* w_kc1; const float* w_kc2;
    const float* pe_vc; const float* w_vc1; const float* w_vc2; const float* w_o; const float* norm2_g;
    const float* w_rg; const float* b_rg; const float* w_re; const float* b_re; const float* w_gate; const float* w_up; const float* w_down; const float* norm_f_g;
    float* out; unsigned char* ws;
};

typedef __bf16 bf16v2 __attribute__((ext_vector_type(2)));
DEV unsigned cvt_pk(float lo, float hi) { bf16v2 v; v.x = (__bf16)lo; v.y = (__bf16)hi; return __builtin_bit_cast(unsigned, v); }
DEV float bf_lo(unsigned u) { return __uint_as_float(u << 16); }
DEV float bf_hi(unsigned u) { return __uint_as_float(u & 0xffff0000u); }
DEV float fexp2(float x) { return __builtin_amdgcn_exp2f(x); }
DEV int perm32(int rho) { const int g = rho >> 3, h = (rho >> 2) & 1, e = rho & 3; return 16 * (g >> 1) + 8 * h + 4 * (g & 1) + e; }
DEV int rope_src(int i) { return i < 16 ? ((i & 1) ? 8 + (i >> 1) : (i >> 1)) : i; }
DEV float xhalf_max(float v) { auto r = __builtin_amdgcn_permlane32_swap(__float_as_uint(v), __float_as_uint(v), false, false); return fmaxf(__uint_as_float(r[0]), __uint_as_float(r[1])); }
DEV float xhalf_sum(float v) { auto r = __builtin_amdgcn_permlane32_swap(__float_as_uint(v), __float_as_uint(v), false, false); return __uint_as_float(r[0]) + __uint_as_float(r[1]); }
DEV int opaque(int v) { asm volatile("" : "+v"(v)); return v; }
DEV int lds_off(int row, int chunk) { return row * 128 + ((chunk ^ ((row >> 1) & 7)) << 4); }

#define XB_TMO      128
#define XB_XCNT(j)  (256  + 64 * (j))
#define XB_XSUB(j)  (1280 + 64 * (j))
#define XB_XGEN(j)  (2304 + 64 * (j))
#define XB_TOP      3328
#define XB_TOPGEN   3392
#define XCD_BAR_WORDS 3456
#define XB_SPIN_CAP (1u << 18)
#define LAS __attribute__((address_space(3)))

__device__ __forceinline__ unsigned xb_ld(unsigned* p)              { return __hip_atomic_load(p, __ATOMIC_RELAXED, __HIP_MEMORY_SCOPE_AGENT); }
__device__ __forceinline__ unsigned xb_add(unsigned* p, unsigned v) { return __hip_atomic_fetch_add(p, v, __ATOMIC_RELAXED, __HIP_MEMORY_SCOPE_AGENT); }
__device__ __forceinline__ unsigned xb_xcc_id() { return (unsigned)__builtin_amdgcn_s_getreg((3 << 11) | 20) & 0xFu; }
#define XB_SPIN(cond, bar) do { unsigned _sp = 0; while (cond) { __builtin_amdgcn_s_sleep(1); \
    if ((++_sp & 255u) == 0u) { if (xb_ld(&(bar)[XB_TMO])) break; if (_sp > XB_SPIN_CAP) { atomicAdd(&(bar)[XB_TMO], 1u); break; } } } } while (0)

struct XcdBarrier { unsigned* bar; unsigned x; volatile LAS unsigned* st; };

__device__ __forceinline__ XcdBarrier xcd_barrier_post(unsigned* bar, volatile LAS unsigned* st) {
    XcdBarrier b; b.bar = bar; b.x = xb_xcc_id(); b.st = st;
    if (threadIdx.x == 0) (void)xb_add(&bar[XB_XCNT(b.x)], 1u);
    return b;
}
__device__ __forceinline__ void xcd_barrier_complete(unsigned* bar, unsigned x, unsigned& nloc, unsigned& nx) {
    const unsigned G = gridDim.x * gridDim.y * gridDim.z;
    unsigned sum, cnt, mine, sp = 0u;
    for (;;) {
        sum = 0u; cnt = 0u; mine = 0u;
#pragma unroll
        for (unsigned j = 0; j < 16; ++j) { const unsigned c = xb_ld(&bar[XB_XCNT(j)]); sum += c; cnt += (c > 0u) ? 1u : 0u; mine = (j == x) ? c : mine; }
        if (sum == G) break;
        __builtin_amdgcn_s_sleep(1);
        if ((++sp & 255u) == 0u) { if (xb_ld(&bar[XB_TMO])) break; if (sp > XB_SPIN_CAP) { atomicAdd(&bar[XB_TMO], 1u); break; } }
    }
    nloc = mine > 0u ? mine : 1u; nx = cnt > 0u ? cnt : 1u;
}
__device__ __forceinline__ void xcd_barrier_impl(const XcdBarrier& b) {
    asm volatile("s_waitcnt vmcnt(0)" ::: "memory");
    __syncthreads();
    if (threadIdx.x == 0) {
        unsigned* bar = b.bar;
        __builtin_amdgcn_s_waitcnt(0);
        unsigned nloc = b.st[0], nx = b.st[1];
        if (nloc == 0u) { xcd_barrier_complete(bar, b.x, nloc, nx); b.st[0] = nloc; b.st[1] = nx; }
        const unsigned old = xb_add(&bar[XB_XSUB(b.x)], 1u);
        const unsigned gen = old / nloc;
        if (old + 1u == (gen + 1u) * nloc) {
            __builtin_amdgcn_fence(__ATOMIC_RELEASE, "agent");
            asm volatile("s_waitcnt vmcnt(0)" ::: "memory");
            const unsigned og = xb_add(&bar[XB_TOP], 1u);
            const unsigned tg = og / nx;
            if (og + 1u == (tg + 1u) * nx) xb_add(&bar[XB_TOPGEN], 1u);
            else XB_SPIN(xb_ld(&bar[XB_TOPGEN]) == tg, bar);
            __builtin_amdgcn_fence(__ATOMIC_ACQUIRE, "agent");
            xb_add(&bar[XB_XGEN(b.x)], 1u);
            asm volatile("s_waitcnt vmcnt(0)" ::: "memory");
        } else {
            XB_SPIN(xb_ld(&bar[XB_XGEN(b.x)]) == gen, bar);
            __builtin_amdgcn_fence(__ATOMIC_ACQUIRE, "agent");
            asm volatile("s_waitcnt vmcnt(0)" ::: "memory");
        }
    }
    __syncthreads();
}

DEV void xcd_barrier(unsigned* barw, volatile LAS unsigned* st) { XcdBarrier b; b.bar = barw; b.x = xb_xcc_id(); b.st = st; xcd_barrier_impl(b); }

template <class F>
DEV void tr_matrix(const F f, bf16_t* dst, int NR, int K, int lomode, LDSP lds) {
    LDS float* tile = (LDS float*)lds;
    const int tid = threadIdx.x, tk = K >> 6, nt = (NR >> 6) * tk;
    for (int t = blockIdx.x; t < nt; t += gridDim.x) {
        const int n0 = (t / tk) << 6, k0 = (t % tk) << 6;
#pragma unroll
        for (int i = 0; i < 8; ++i) { const int kk = (tid >> 6) + 8 * i, nn = tid & 63; tile[kk * 65 + nn] = f(n0 + nn, k0 + kk); }
        __syncthreads();
        {
            const int nn = tid >> 3, k8 = (tid & 7) * 8; float v[8];
#pragma unroll
            for (int j = 0; j < 8; ++j) { v[j] = tile[(k8 + j) * 65 + nn]; if (lomode) v[j] = v[j] - bf_lo(cvt_pk(v[j], 0.f) & 0xffffu); }
            u32x4 w; w.x = cvt_pk(v[0], v[1]); w.y = cvt_pk(v[2], v[3]); w.z = cvt_pk(v[4], v[5]); w.w = cvt_pk(v[6], v[7]);
            *(u32x4*)(dst + (size_t)(n0 + nn) * K + k0 + k8) = w;
        }
        __syncthreads();
    }
}
struct SrcWin { const float* w; const float* g1;
    DEV float operator()(int R, int k) const {
        const int c = R;
        if (c >= NPROJ) return 0.f;
        const bool rp = (c < 1024) || (c >= 1536 && c < 2048) || (c >= 2304 && c < 2432) || (c >= 2560 && c < 2688);
        const int src = rp ? (c & ~63) + rope_src(c & 63) : c;
        const float sc = (c < 512 || (c >= 1536 && c < 2048)) ? SCQ : 1.f;
        return w[(size_t)k * NPROJ + src] * g1[k] * sc; } };
struct SrcWo { const float* w; DEV float operator()(int R, int k) const { return w[(size_t)k * 1024 + R]; } };
DEV const float* psel(const float* a, const float* b, int pick_b) { return (const float*)((uintptr_t)a + (pick_b ? ((uintptr_t)b - (uintptr_t)a) : (uintptr_t)0)); }
struct SrcWc1 { const float* wk; const float* wv; DEV float operator()(int R, int k) const { const float* w = psel(wk, wv, R >> 8); const int r = R & 255; return w[(size_t)k * 256 + r]; } };
struct SrcWc2 { const float* wk; const float* wv;
    DEV float operator()(int R, int k) const { const int kv = R >> 8, r = R & 255, c = r; if (c >= 64) return 0.f;
        return psel(wk, wv, kv)[(size_t)k * 64 + (kv ? c : rope_src(c))]; } };
struct SrcWr { const float* wrg; const float* wre; const float* g2;
    DEV float operator()(int R, int k) const { if (R >= 96) return 0.f; const int c = (R & ~31) + perm32(R & 31), lb = c >> 3, ix = c & 7;
        if (lb > 8) return 0.f; const size_t off = lb == 0 ? (size_t)k * 8 + ix : (size_t)k * 64 + (lb - 1) * 8 + ix; return psel(wrg, wre, lb != 0)[off] * g2[k]; } };
struct SrcWgu { const float* wg; const float* wu; const float* g2;
    DEV float operator()(int R, int k) const { const int e = R >> 9, r = R & 511, pn = r >> 8, bj = (r >> 7) & 1, j = pn * 128 + (r & 127);
        const float* w = psel(wg, wu, bj); return w[((size_t)e * 1024 + k) * 256 + j] * g2[k]; } };
struct SrcWd { const float* w; DEV float operator()(int R, int k) const { const int e = R >> 10, r = R & 1023, sl = r & 255, col = (r & ~255) + ((sl >> 5) & 3) * 64 + (sl >> 7) * 32 + (sl & 31); return w[((size_t)e * 256 + k) * 1024 + col]; } };

DEV void p0_prologue(const Params& p, LDSP lds) {
    unsigned char* ws = p.ws;
    const int tid = threadIdx.x, lane = tid & 63, wid = tid >> 6, bid = blockIdx.x;
    { const int idx = bid * 512 + tid; if (idx < 2048 * 8) { const int pos = idx >> 3, pp = idx & 7;
        const float invf = (float)pow(500000.0, -(double)pp / 8.0); const float ang = (float)pos * invf;
        ((float*)(ws + OFF_ROPEC))[idx] = (float)cos((double)ang); ((float*)(ws + OFF_ROPES))[idx] = (float)sin((double)ang); } }
    if (bid < 16) { const int kv = bid & 1, jb = (bid >> 1) * 32, j = jb + (tid & 31), part = tid >> 5; const float* pe = psel(p.pe_kc, p.pe_vc, kv); const float* w1 = psel(p.w_kc1, p.w_vc1, kv);
        float a = 0.f; const int k0 = part * 128;
        for (int kk = k0; kk < k0 + 128; ++kk) a += pe[kk] * w1[(size_t)kk * 256 + j];
        LDS float* red = (LDS float*)lds; red[part * 32 + (tid & 31)] = a;
        __syncthreads();
        if (tid < 32) { float t = 0.f; for (int q = 0; q < 16; ++q) t += red[q * 32 + tid]; ((float*)(ws + OFF_BIAS1))[kv * 256 + jb + tid] = t; }
        __syncthreads(); }
    { bf16_t* HB = (bf16_t*)(ws + OFF_R1);
      for (int row = bid * 8 + wid; row < T_TOK; row += 8192) {
        f32x4 v[4][4]; float ss[4];
#pragma unroll
        for (int j = 0; j < 4; ++j) { const float* xr = p.x + (size_t)(row + 2048 * j) * 1024;
#pragma unroll
          for (int i = 0; i < 4; ++i) v[j][i] = *(const f32x4*)(xr + i * 256 + lane * 4); }
#pragma unroll
        for (int j = 0; j < 4; ++j) { ss[j] = 0.f;
#pragma unroll
          for (int i = 0; i < 4; ++i) ss[j] += v[j][i][0] * v[j][i][0] + v[j][i][1] * v[j][i][1] + v[j][i][2] * v[j][i][2] + v[j][i][3] * v[j][i][3]; }
#pragma unroll
        for (int o = 32; o > 0; o >>= 1) {
#pragma unroll
          for (int j = 0; j < 4; ++j) ss[j] += __shfl_xor(ss[j], o); }
#pragma unroll
        for (int j = 0; j < 4; ++j) { const float rs = 1.0f / sqrtf(ss[j] * (1.0f / 1024.0f) + EPSN);
#pragma unroll
          for (int i = 0; i < 4; ++i) { u32x2 w; w.x = cvt_pk(v[j][i][0] * rs, v[j][i][1] * rs); w.y = cvt_pk(v[j][i][2] * rs, v[j][i][3] * rs); *(u32x2*)(HB + (size_t)(row + 2048 * j) * 1024 + i * 256 + lane * 4) = w; } }
      } }
    tr_matrix(SrcWin{p.w_in, p.norm1_g}, (bf16_t*)(ws + OFF_WINT), NPAD, 1024, 0, lds);
    tr_matrix(SrcWo{p.w_o}, (bf16_t*)(ws + OFF_WOT), 1024, 1024, 0, lds);
    tr_matrix(SrcWc1{p.w_kc1, p.w_vc1}, (bf16_t*)(ws + OFF_WC1T), 512, 2048, 0, lds);
    tr_matrix(SrcWc2{p.w_kc2, p.w_vc2}, (bf16_t*)(ws + OFF_WC2T), 512, 256, 0, lds);
    tr_matrix(SrcWr{p.w_rg, p.w_re, p.norm2_g}, (bf16_t*)(ws + OFF_WRT), 128, 1024, 0, lds);
    tr_matrix(SrcWr{p.w_rg, p.w_re, p.norm2_g}, (bf16_t*)(ws + OFF_WRT) + 128 * 1024, 128, 1024, 1, lds);
    tr_matrix(SrcWgu{p.w_gate, p.w_up, p.norm2_g}, (bf16_t*)(ws + OFF_WGUT), 64 * 512, 1024, 0, lds);
    tr_matrix(SrcWd{p.w_down}, (bf16_t*)(ws + OFF_WDT), 64 * 1024, 256, 0, lds);
}

#define GLDS16(src, dstoff) __builtin_amdgcn_global_load_lds((const unsigned*)(src), (LDS unsigned*)(lds + (dstoff)), 16, 0, 0)
namespace pg {
constexpr int BM = 256, BK = 64, HALF = 128, HTB = HALF * BK * 2, STAGE_BYTES = 8 * HTB;
DEV int lds_byte(int r, int c) { const int st = (r >> 4) * 2 + (c >> 5), rr = r & 15, cc = c & 31, ob = rr * 64 + cc * 2; return st * 1024 + (ob ^ (((ob >> 9) & 1) << 5)); }
DEV void stage_rc(int b, int& R, int& C) { const int st = b / 1024, sb = b % 1024, swz = sb ^ (((sb >> 9) & 1) << 5); R = (st >> 1) * 16 + swz / 64; C = (st & 1) * 32 + (swz % 64) / 2; }
DEV int pg_perm32(int rho) { const int n = rho >> 4, i = rho & 15; return 8 * (i >> 2) + 4 * n + (i & 3); }
struct Unit { const char* a; const char* b; int pm, pn, x0, x1, x2; };
typedef f32x4 Acc[2][2][4][2];

template <class Epi, class Sched, bool ALIGN_EPI, bool GATHER>
DEV void gemm_phase(LDSP lds, int K_, int lda, const Sched& S, const Epi& E) {
    int K = K_; asm volatile("" : "+s"(K));
    const int tid = opaque((int)threadIdx.x), wid = __builtin_amdgcn_readfirstlane(tid >> 6), lane = tid & 63, wr = wid >> 2, wc = wid & 3, fr = lane & 15, fq = lane >> 4;
    const int nt = K / BK;
    Unit cur, nxt; int ui = 0;
    if (!S.next(0, cur)) return;
    unsigned voffA0[2], voffA1[2], voffB[2], nvA0[2], nvA1[2]; int sR[2], sC[2];
#pragma unroll
    for (int i = 0; i < 2; ++i) { int R, C; stage_rc(tid * 16 + i * 8192, R, C); sR[i] = R; sC[i] = C; const int Rb = (R & ~31) + pg_perm32(R & 31);
        if constexpr (GATHER) { voffA0[i] = (S.arow(cur, R) + (unsigned)C) * 2u; voffA1[i] = (S.arow(cur, R + HALF) + (unsigned)C) * 2u; }
        else { voffA0[i] = (unsigned)(R * lda + C) * 2u; voffA1[i] = (unsigned)((R + HALF) * lda + C) * 2u; }
        nvA0[i] = voffA0[i]; nvA1[i] = voffA1[i];
        voffB[i] = (unsigned)(Rb * K + C) * 2u; }
    const size_t kstep = (size_t)(BK * 2);
    const size_t hstepB = (size_t)HALF * K * 2;
    const unsigned ldsw = (unsigned)wid * 1024u;
    const int aoff = lds_byte(wr * 64 + fr, fq * 8), boff = lds_byte(wc * 32 + fr, fq * 8);
#define PG_SA(b, h) (((b) * 2 + (h)) * HTB)
#define PG_SB(b, h) ((4 + (b) * 2 + (h)) * HTB)
#define PG_STAGE(bufoff, gbase, voff) do { _Pragma("unroll") for (int _i = 0; _i < 2; ++_i) GLDS16((const char*)(gbase) + (voff)[_i], (bufoff) + ldsw + _i * 8192); } while (0)
#define PG_LDA(dst, b, h) do { _Pragma("unroll") for (int m = 0; m < 4; ++m) _Pragma("unroll") for (int k = 0; k < 2; ++k) dst[m][k] = *(const LDS bf16x8*)(lds + PG_SA(b, h) + aoff + m * 2048 + k * 1024); } while (0)
#define PG_LDB(dst, b, h) do { _Pragma("unroll") for (int n = 0; n < 2; ++n) _Pragma("unroll") for (int k = 0; k < 2; ++k) dst[n][k] = *(const LDS bf16x8*)(lds + PG_SB(b, h) + boff + n * 2048 + k * 1024); } while (0)
#define PG_MMA(ai, bj, At, Bt) do { __builtin_amdgcn_s_setprio(1); _Pragma("unroll") for (int m = 0; m < 4; ++m) _Pragma("unroll") for (int n = 0; n < 2; ++n) _Pragma("unroll") for (int k = 0; k < 2; ++k) \
        acc[ai][bj][m][n] = __builtin_amdgcn_mfma_f32_16x16x32_bf16(Bt[n][k], At[m][k], acc[ai][bj][m][n], 0, 0, 0); __builtin_amdgcn_s_setprio(0); } while (0)
#define PG_WAIT_V(n) asm volatile("s_waitcnt vmcnt(" #n ")" ::: "memory")
#define PG_WAIT_L(n) asm volatile("s_waitcnt lgkmcnt(" #n ")" ::: "memory")
#define PG_BAR __builtin_amdgcn_s_barrier()
#define PG_SCHED __builtin_amdgcn_sched_barrier(0)
    Acc acc;
#pragma unroll
    for (int a = 0; a < 2; ++a)
#pragma unroll
        for (int b = 0; b < 2; ++b)
#pragma unroll
            for (int m = 0; m < 4; ++m)
#pragma unroll
                for (int n = 0; n < 2; ++n) acc[a][b][m][n] = (f32x4){0.f, 0.f, 0.f, 0.f};
    bf16x8 At[4][2], B0[2][2], B1[2][2];
    const char* cA = cur.a; const char* cB = cur.b;
    PG_STAGE(PG_SB(0, 0), cB, voffB); PG_STAGE(PG_SB(0, 1), cB + hstepB, voffB); PG_STAGE(PG_SA(0, 0), cA, voffA0); PG_STAGE(PG_SA(0, 1), cA, voffA1);
    if (wr == 1) PG_BAR;
    PG_WAIT_V(2); PG_BAR;
    PG_STAGE(PG_SB(1, 0), cB + kstep, voffB); PG_STAGE(PG_SA(1, 0), cA + kstep, voffA0); PG_STAGE(PG_SB(1, 1), cB + hstepB + kstep, voffB);
    PG_WAIT_V(6); PG_BAR;
    for (;;) {
        const bool has_next = S.next(ui + 1, nxt);
        const char* nA = has_next ? nxt.a : cA; const char* nB = has_next ? nxt.b : cB;
        if constexpr (GATHER) { if (has_next) {
#pragma unroll
            for (int i = 0; i < 2; ++i) { nvA0[i] = (S.arow(nxt, sR[i]) + (unsigned)sC[i]) * 2u; nvA1[i] = (S.arow(nxt, sR[i] + HALF) + (unsigned)sC[i]) * 2u; } } }
        for (int t = 0; t < nt; t += 2) {
            const bool last = (t == nt - 2);
            const char* a1 = cA + (size_t)(t + 1) * kstep;
            const char* a2 = last ? nA : cA + (size_t)(t + 2) * kstep; const char* b2 = last ? nB : cB + (size_t)(t + 2) * kstep;
            const char* a3 = a2 + kstep; const char* b3 = b2 + kstep;
            unsigned w0[2], w1[2];
#pragma unroll
            for (int i = 0; i < 2; ++i) { w0[i] = (GATHER && last) ? nvA0[i] : voffA0[i]; w1[i] = (GATHER && last) ? nvA1[i] : voffA1[i]; }
            PG_LDB(B0, 0, 0); PG_LDB(B1, 0, 1); PG_SCHED; PG_LDA(At, 0, 0); PG_STAGE(PG_SA(1, 1), a1, voffA1);
            PG_WAIT_V(8); PG_WAIT_L(0); PG_BAR; PG_MMA(0, 0, At, B0); PG_MMA(0, 1, At, B1); PG_BAR; PG_SCHED;
            PG_LDA(At, 0, 1); PG_STAGE(PG_SB(0, 0), b2, voffB); PG_STAGE(PG_SB(0, 1), b2 + hstepB, voffB); PG_STAGE(PG_SA(0, 0), a2, w0);
            PG_WAIT_V(8); PG_WAIT_L(0); PG_BAR; PG_MMA(1, 0, At, B0); PG_MMA(1, 1, At, B1); PG_BAR; PG_SCHED;
            PG_LDB(B0, 1, 0); PG_LDB(B1, 1, 1); PG_SCHED; PG_LDA(At, 1, 0); PG_STAGE(PG_SA(0, 1), a2, w1);
            PG_WAIT_V(8); PG_WAIT_L(0); PG_BAR; PG_MMA(0, 0, At, B0); PG_MMA(0, 1, At, B1); PG_BAR; PG_SCHED;
            PG_LDA(At, 1, 1); PG_STAGE(PG_SB(1, 0), b3, voffB); PG_STAGE(PG_SB(1, 1), b3 + hstepB, voffB); PG_STAGE(PG_SA(1, 0), a3, w0);
            PG_WAIT_V(8); PG_WAIT_L(0); PG_BAR; PG_MMA(1, 0, At, B0); PG_MMA(1, 1, At, B1); PG_BAR; PG_SCHED;
        }
        if constexpr (ALIGN_EPI) { if (wr == 0) PG_BAR; }
        E(acc, cur, wr, wc, fr, fq);
        if (!has_next) break;
#pragma unroll
        for (int a = 0; a < 2; ++a)
#pragma unroll
            for (int b = 0; b < 2; ++b)
#pragma unroll
                for (int m = 0; m < 4; ++m)
#pragma unroll
                    for (int n = 0; n < 2; ++n) acc[a][b][m][n] = (f32x4){0.f, 0.f, 0.f, 0.f};
        cur = nxt; cA = nA; cB = nB; ++ui;
        if constexpr (GATHER) {
#pragma unroll
            for (int i = 0; i < 2; ++i) { voffA0[i] = nvA0[i]; voffA1[i] = nvA1[i]; } }
        if constexpr (ALIGN_EPI) { if (wr == 1) PG_BAR; }
    }
    PG_WAIT_V(0);
    if constexpr (!ALIGN_EPI) { if (wr == 0) PG_BAR; }
    PG_BAR;
#undef PG_SA
#undef PG_SB
#undef PG_STAGE
#undef PG_LDA
#undef PG_LDB
#undef PG_MMA
#undef PG_WAIT_V
#undef PG_WAIT_L
#undef PG_BAR
#undef PG_SCHED
}
}

DEV u32x4 pack8(const float (&v)[8]) { u32x4 w; w.x = cvt_pk(v[0], v[1]); w.y = cvt_pk(v[2], v[3]); w.z = cvt_pk(v[4], v[5]); w.w = cvt_pk(v[6], v[7]); return w; }
#define PACC8(v, acc, ai, bj, m) { _Pragma("unroll") for (int _e = 0; _e < 4; ++_e) { v[_e] = acc[ai][bj][m][0][_e]; v[4 + _e] = acc[ai][bj][m][1][_e]; } }

struct OrderXcd { const char* A; const char* Bt; size_t astep, bstep; int NT, rounds, xcd, ci;
    DEV bool next(int i, pg::Unit& u) const { if (i >= rounds) return false; const int q = i * 32 + ci, per = 4 * NT, mg = q / per, rem = q % per;
        u.pn = rem >> 2; u.pm = xcd * 32 + mg * 4 + (rem & 3); u.a = A + (size_t)u.pm * astep; u.b = Bt + (size_t)u.pn * bstep; u.x0 = 0; u.x1 = 0; u.x2 = 0; return true; } };
struct OrderOne { pg::Unit u;
    DEV bool next(int i, pg::Unit& o) const { if (i) return false; o = u; return true; } };
struct OrderMoe1 { const char* X; const char* WGU; const unsigned* LISTB; const unsigned* cntp; LDS const int* tb; int ntile, bid;
    DEV bool next(int i, pg::Unit& u) const { const int q = bid + 256 * i; if (q >= ntile * 2) return false; const int rt = q >> 1, nt = q & 1, e = __builtin_amdgcn_readfirstlane(tb[128 + rt]);
        u.pm = rt; u.pn = nt; u.x0 = e; u.x1 = (rt - __builtin_amdgcn_readfirstlane(tb[e])) * 256; u.x2 = (int)cntp[e]; u.a = X; u.b = WGU + (size_t)(e * 512 + nt * 256) * 1024 * 2; return true; }
    DEV unsigned arow(const pg::Unit& u, int r) const { const int pos = u.x1 + r; return (pos < u.x2 ? (LISTB[(size_t)u.x0 * 65536 + pos] >> 1) : 0u) * 1024u; } };
struct OrderMoe2 { const char* HE; const char* WDT; LDS const int* tb; int ntile, bid;
    DEV bool next(int i, pg::Unit& u) const { const int q = bid + 256 * i; if (q >= ntile * 4) return false; const int rt = q >> 2, nt = q & 3, e = __builtin_amdgcn_readfirstlane(tb[128 + rt]);
        u.pm = rt; u.pn = nt; u.x0 = e; u.x1 = 0; u.x2 = 0; u.a = HE + (size_t)rt * 256 * 256 * 2; u.b = WDT + (size_t)(e * 1024 + nt * 256) * 256 * 2; return true; } };

struct EpiInProj { unsigned char* ws;
    DEV void operator()(const pg::Acc& acc, const pg::Unit& u, int wr, int wc, int fr, int fq) const {
        const float* rc = (const float*)(ws + OFF_ROPEC); const float* rsn = (const float*)(ws + OFF_ROPES);
        const int tok0 = u.pm * 256 + wr * 64 + fr, b = tok0 >> 11, s0 = tok0 & 2047;
#pragma unroll
        for (int bj = 0; bj < 2; ++bj) {
            const int cu = u.pn * 256 + bj * 128 + wc * 32;
            const int c = cu + 8 * fq;
            if (cu >= 2816) {
                if (c < NPROJ) {
#pragma unroll
                    for (int ai = 0; ai < 2; ++ai)
#pragma unroll
                        for (int m = 0; m < 4; ++m) { const int tok = tok0 + ai * 128 + m * 16; float v[8]; PACC8(v, acc, ai, bj, m);
                            float* g = (float*)(ws + OFF_GATE) + (size_t)tok * 24 + (c - 2816); f32x4 a, d;
#pragma unroll
                            for (int i = 0; i < 4; ++i) { a[i] = 1.f / (1.f + __expf(-v[i])); d[i] = 1.f / (1.f + __expf(-v[4 + i])); }
                            *(f32x4*)g = a; *(f32x4*)(g + 4) = d; } }
                continue;
            }
            size_t base; int head, nh; bool rp;
            if (cu < 2048) { const int reg = cu >> 9; base = OFF_R2 + (size_t)reg * (64 * MB); head = (cu & 511) >> 6; nh = 8; rp = (reg != 2); }
            else { const int reg = (cu - 2048) >> 7; base = OFF_KV6 + (size_t)reg * (16 * MB); head = ((cu - 2048) & 127) >> 6; nh = 2; rp = (reg == 2 || reg == 4); }
            bf16_t* dst0 = (bf16_t*)(ws + base) + ((size_t)(b * nh + head) * 2048 + s0) * 64 + (c & 63);
            if (rp && (cu & 63) == 0) {
                const int p0 = (c & 31) >> 1;
                f32x4 cs[8], sn[8];
#pragma unroll
                for (int q = 0; q < 8; ++q) { const int srow = s0 + (q >> 2) * 128 + (q & 3) * 16; cs[q] = *(const f32x4*)(rc + srow * 8 + (p0 & 4)); sn[q] = *(const f32x4*)(rsn + srow * 8 + (p0 & 4)); }
#pragma unroll
                for (int q = 0; q < 8; ++q) { const int ai = q >> 2, m = q & 3; float v[8]; PACC8(v, acc, ai, bj, m);
                    if (fq < 2) {
#pragma unroll
                        for (int pr = 0; pr < 4; ++pr) { const float x1 = v[2 * pr], x2 = v[2 * pr + 1]; v[2 * pr] = x1 * cs[q][pr] - x2 * sn[q][pr]; v[2 * pr + 1] = x2 * cs[q][pr] + x1 * sn[q][pr]; } }
                    __builtin_nontemporal_store(pack8(v), (u32x4*)(dst0 + (size_t)(ai * 128 + m * 16) * 64)); }
            } else {
#pragma unroll
                for (int q = 0; q < 8; ++q) { const int ai = q >> 2, m = q & 3; float v[8]; PACC8(v, acc, ai, bj, m);
                    __builtin_nontemporal_store(pack8(v), (u32x4*)(dst0 + (size_t)(ai * 128 + m * 16) * 64)); }
            }
        }
    }
};

DEV float gelu_tanh(float x) { const float u = 0.7978845608028654f * (x + 0.044715f * x * x * x); return 0.5f * x * (1.f + tanhf(u)); }
struct EpiCmp1 { unsigned char* ws; int kv;
    DEV void operator()(const pg::Acc& acc, const pg::Unit& u, int wr, int wc, int fr, int fq) const {
        const float* bias = (const float*)(ws + OFF_BIAS1) + kv * 256;
        bf16_t* HID = (bf16_t*)(ws + OFF_HID) + (size_t)kv * 8192 * 256;
#pragma unroll
        for (int ai = 0; ai < 2; ++ai)
#pragma unroll
            for (int m = 0; m < 4; ++m) { const int R = u.pm * 256 + ai * 128 + wr * 64 + m * 16 + fr;
#pragma unroll
                for (int bj = 0; bj < 2; ++bj) { const int n = bj * 128 + wc * 32 + 8 * fq; float v[8]; PACC8(v, acc, ai, bj, m);
#pragma unroll
                    for (int i = 0; i < 8; ++i) v[i] = gelu_tanh(v[i] + bias[n + i]);
                    *(u32x4*)(HID + (size_t)R * 256 + n) = pack8(v); } }
    }
};
struct EpiCmp2 { unsigned char* ws; int kv;
    DEV void operator()(const pg::Acc& acc, const pg::Unit& u, int wr, int wc, int fr, int fq) const {
        if (wc >= 2) return;
        const float* rc = (const float*)(ws + OFF_ROPEC); const float* rsn = (const float*)(ws + OFF_ROPES);
        bf16_t* OUT = (bf16_t*)(ws + (kv ? OFF_VC : OFF_KC));
#pragma unroll
        for (int ai = 0; ai < 2; ++ai)
#pragma unroll
            for (int m = 0; m < 4; ++m) { const int R = u.pm * 256 + ai * 128 + wr * 64 + m * 16 + fr, cidx = R & 127;
                const int n = wc * 32 + 8 * fq; float v[8]; PACC8(v, acc, ai, 0, m);
                if (kv == 0 && n < 16) { const int pos = (cidx < 127 ? cidx : 126) * 16 + 31, p0 = n >> 1;
                    const f32x4 cs = *(const f32x4*)(rc + pos * 8 + p0), sn = *(const f32x4*)(rsn + pos * 8 + p0);
#pragma unroll
                    for (int pr = 0; pr < 4; ++pr) { const float x1 = v[2 * pr], x2 = v[2 * pr + 1]; v[2 * pr] = x1 * cs[pr] - x2 * sn[pr]; v[2 * pr + 1] = x2 * cs[pr] + x1 * sn[pr]; } }
                if (cidx == 127) {
#pragma unroll
                    for (int i = 0; i < 8; ++i) v[i] = 0.f; }
                *(u32x4*)(OUT + (size_t)R * 64 + n) = pack8(v); }
    }
};

struct EpiOut { unsigned char* ws; const float* x;
    DEV void operator()(const pg::Acc& acc, const pg::Unit& u, int wr, int wc, int fr, int fq) const {
        bf16_t* XB = (bf16_t*)(ws + OFF_X1B); bf16_t* XL = (bf16_t*)(ws + OFF_X1L);
#pragma unroll
        for (int ai = 0; ai < 2; ++ai)
#pragma unroll
            for (int m = 0; m < 4; ++m) { const int tok = u.pm * 256 + ai * 128 + wr * 64 + m * 16 + fr;
#pragma unroll
                for (int bj = 0; bj < 2; ++bj) { const int n = u.pn * 256 + bj * 128 + wc * 32 + 8 * fq; float v[8], lo[8]; PACC8(v, acc, ai, bj, m);
                    const f32x4 xa = *(const f32x4*)(x + (size_t)tok * 1024 + n), xb = *(const f32x4*)(x + (size_t)tok * 1024 + n + 4);
#pragma unroll
                    for (int i = 0; i < 4; ++i) { v[i] += xa[i]; v[4 + i] += xb[i]; }
                    const u32x4 h = pack8(v);
                    lo[0] = v[0] - bf_lo(h.x); lo[1] = v[1] - bf_hi(h.x); lo[2] = v[2] - bf_lo(h.y); lo[3] = v[3] - bf_hi(h.y);
                    lo[4] = v[4] - bf_lo(h.z); lo[5] = v[5] - bf_hi(h.z); lo[6] = v[6] - bf_lo(h.w); lo[7] = v[7] - bf_hi(h.w);
                    *(u32x4*)(XB + (size_t)tok * 1024 + n) = h; *(u32x4*)(XL + (size_t)tok * 1024 + n) = pack8(lo); } }
    }
};

struct EpiMoe1 { unsigned char* ws;
    DEV void operator()(const pg::Acc& acc, const pg::Unit& u, int wr, int wc, int fr, int fq) const {
        const float* RS = (const float*)(ws + OFF_RSTD2); bf16_t* HE = (bf16_t*)(ws + OFF_HE); const unsigned* list = (const unsigned*)(ws + OFF_LIST) + (size_t)u.x0 * 65536;
#pragma unroll
        for (int ai = 0; ai < 2; ++ai)
#pragma unroll
            for (int m = 0; m < 4; ++m) { const int lr = ai * 128 + wr * 64 + m * 16 + fr, pos = u.x1 + lr; const int tok = pos < u.x2 ? (int)(list[pos] >> 1) : 0; const float r = RS[tok];
                const int j = u.pn * 128 + wc * 32 + 8 * fq; float g[8], up[8], v[8]; PACC8(g, acc, ai, 0, m); PACC8(up, acc, ai, 1, m);
#pragma unroll
                for (int i = 0; i < 8; ++i) { const float a = g[i] * r; v[i] = a / (1.f + __expf(-a)) * (up[i] * r); }
                *(u32x4*)(HE + (size_t)(u.pm * 256 + lr) * 256 + j) = pack8(v); }
    }
};
struct EpiMoe2 { unsigned char* ws;
    DEV void operator()(const pg::Acc& acc, const pg::Unit& u, int wr, int wc, int fr, int fq) const {
        bf16_t* Y = (bf16_t*)(ws + OFF_Y);
        const bool lowr = fr < 8;
        const int col = u.pn * 256 + wc * 64 + (fr >> 3) * 32 + 8 * fq;
#pragma unroll
        for (int ai = 0; ai < 2; ++ai)
#pragma unroll
            for (int m = 0; m < 4; ++m) { const int rb = u.pm * 256 + ai * 128 + wr * 64 + m * 16 + (fr & 7);
                float v0[8], v1[8]; PACC8(v0, acc, ai, 0, m); PACC8(v1, acc, ai, 1, m);
                const u32x4 p0 = pack8(v0), p1 = pack8(v1);
                u32x4 snd, rcv;
#pragma unroll
                for (int i = 0; i < 4; ++i) { snd[i] = lowr ? p1[i] : p0[i]; rcv[i] = (unsigned)__builtin_amdgcn_update_dpp(0, (int)snd[i], 0x128  , 0xf, 0xf, false); }
                u32x4 sx, sy;
#pragma unroll
                for (int i = 0; i < 4; ++i) { sx[i] = lowr ? p0[i] : rcv[i]; sy[i] = lowr ? rcv[i] : p1[i]; }
                __builtin_nontemporal_store(sx, (u32x4*)(Y + (size_t)rb * 1024 + col));
                __builtin_nontemporal_store(sy, (u32x4*)(Y + (size_t)(rb + 8) * 1024 + col)); }
    }
};

struct Flash { f32x16 o0, o1; float m, l; };
DEV void flash_init(Flash& s) {
#pragma unroll
    for (int i = 0; i < 16; ++i) { s.o0[i] = 0.f; s.o1[i] = 0.f; }
    s.m = -INFINITY; s.l = 0.f; }
DEV s16x4 tr_read(LDSP p) { return __builtin_bit_cast(s16x4, __builtin_amdgcn_ds_read_tr16_b64_v4i16((LDS s16x4*)p)); }

DEV void flash_stage(const u32x4 (&kch)[4], const u32x4 (&vch)[4], LDSP vl, int lane) {
    const int c = lane & 7, row = lane >> 3; const int wo = (c >> 2) * 2048 + row * 64 + (c & 3) * 16;
#pragma unroll
    for (int i = 0; i < 4; ++i) { const int r = row + 8 * i; *(LDS u32x4*)(vl + 4096 + r * 128 + ((c ^ ((r >> 1) & 7)) << 4)) = kch[i]; *(LDS u32x4*)(vl + wo + i * 512) = vch[i]; }
}
DEV void flash_tile(Flash& st, const bf16x8 (&qf)[4], LDSP vl, int rl, int rh, int lane) {
    const int hl = lane >> 5, l31 = lane & 31;
    asm volatile("s_waitcnt lgkmcnt(0)" ::: "memory");
    f32x16 s;
#pragma unroll
    for (int i = 0; i < 16; ++i) s[i] = 0.f;
#pragma unroll
    for (int ks = 0; ks < 4; ++ks) { const bf16x8 kf = *(const LDS bf16x8*)(vl + 4096 + l31 * 128 + (((2 * ks + hl) ^ ((l31 >> 1) & 7)) << 4)); s = MFMA32(kf, qf[ks], s); }
    float mx = -INFINITY;
    const bool lfull = (rl <= 0) && (rh >= 27), lnone = (rh < 0) || (rl > 27) || (rh < rl);
    bool lane_off = false;
    const bool interior = __all(lfull || lnone);
    if (__builtin_expect(interior, 1)) {
#pragma unroll
        for (int i = 0; i < 16; ++i) mx = fmaxf(mx, s[i]);
        lane_off = !lfull; mx = lane_off ? -INFINITY : mx;
    } else {
#pragma unroll
        for (int i = 0; i < 16; ++i) { const int ci = (i & 3) + 8 * (i >> 2); const bool ok = (ci >= rl) && (ci <= rh); mx = fmaxf(mx, ok ? s[i] : -INFINITY); }
    }
    mx = xhalf_max(mx);
    float rs = 0.f;
    const bool grow = mx > st.m + 8.0f;
    const bool moved = __any(grow);
    const float mnew = grow ? mx : st.m, ms = (mnew == -INFINITY) ? 0.f : mnew;
    const float alpha = fexp2(st.m - ms);
    const float msub = lane_off ? INFINITY : ms;
    float pe[16];
#pragma unroll
    for (int i = 0; i < 16; ++i) pe[i] = fexp2(s[i] - msub);
    if (__builtin_expect(!interior, 0)) {
#pragma unroll
        for (int i = 0; i < 16; ++i) { const int ci = (i & 3) + 8 * (i >> 2); const bool ok = (ci >= rl) && (ci <= rh); pe[i] = ok ? pe[i] : 0.f; }
    }
#pragma unroll
    for (int i = 0; i < 16; ++i) rs += pe[i];
    st.l = st.l * alpha + rs; st.m = mnew;
    if (__builtin_expect(moved, 0)) {
#pragma unroll
        for (int i = 0; i < 16; ++i) { st.o0[i] *= alpha; st.o1[i] *= alpha; }
    }
    unsigned pk[8];
#pragma unroll
    for (int j = 0; j < 8; ++j) pk[j] = cvt_pk(pe[2 * j], pe[2 * j + 1]);
    asm volatile("s_waitcnt lgkmcnt(0)" ::: "memory");
    const int rb = (hl * 4 + ((lane & 15) >> 2)) * 64 + ((lane >> 4) & 1) * 32 + (lane & 3) * 8;
#pragma unroll
    for (int s2 = 0; s2 < 2; ++s2) {
        u32x4 pw; pw.x = pk[4 * s2]; pw.y = pk[4 * s2 + 1]; pw.z = pk[4 * s2 + 2]; pw.w = pk[4 * s2 + 3];
        const bf16x8 pf = __builtin_bit_cast(bf16x8, pw);
        { const s16x4 v0 = tr_read(vl + (16 * s2) * 64 + rb), v1 = tr_read(vl + (16 * s2 + 8) * 64 + rb);
          const bf16x8 vf = __builtin_shufflevector(v0, v1, 0, 1, 2, 3, 4, 5, 6, 7); st.o0 = MFMA32(vf, pf, st.o0); }
        { const s16x4 v0 = tr_read(vl + 2048 + (16 * s2) * 64 + rb), v1 = tr_read(vl + 2048 + (16 * s2 + 8) * 64 + rb);
          const bf16x8 vf = __builtin_shufflevector(v0, v1, 0, 1, 2, 3, 4, 5, 6, 7); st.o1 = MFMA32(vf, pf, st.o1); }
    }
    asm volatile("s_waitcnt lgkmcnt(0)" ::: "memory");
}
DEV bool tile_need(int kt, int lo, int hi, unsigned selmask) { const int kb = kt * 32; const int hie = ((selmask >> (kt >> 1)) & 1u) ? hi : -1; return (hie >= kb) && (lo <= kb + 31) && (hie >= lo); }
#define FR_NEXT(k) do { ++(k); while ((k) < kt1 && !__any(tile_need((k), lo, hi, selmask))) ++(k); } while (0)
#define FR_LOAD(KR, VR, k) do { _Pragma("unroll") for (int i_ = 0; i_ < 4; ++i_) { KR[i_] = *(const u32x4*)(kp + (size_t)((k) * 32 + 8 * i_) * stride); VR[i_] = *(const u32x4*)(vp + (size_t)((k) * 32 + 8 * i_) * stride); } } while (0)
DEV void flash_range(Flash& st, const bf16x8 (&qf)[4], const bf16_t* kbase, const bf16_t* vbase, int stride, int kt0, int kt1, int lo, int hi, unsigned selmask, LDSP vl, int lane) {
    const int hl = lane >> 5;
    const bf16_t* kp = kbase + (size_t)(lane >> 3) * stride + (lane & 7) * 8;
    const bf16_t* vp = vbase + (size_t)(lane >> 3) * stride + (lane & 7) * 8;
    int ta = kt0 - 1; FR_NEXT(ta);
    if (ta >= kt1) return;
    u32x4 kA[4], vA[4], kB[4], vB[4];
    FR_LOAD(kA, vA, ta);
    int tb = ta; FR_NEXT(tb);
    if (tb < kt1) FR_LOAD(kB, vB, tb);
    int cur = 0;
    flash_stage(kA, vA, vl, lane);
    int tc = tb; if (tb < kt1) { FR_NEXT(tc); if (tc < kt1) FR_LOAD(kA, vA, tc); }
    for (;;) {
        { const int kb = ta * 32; const int hie = ((selmask >> (ta >> 1)) & 1u) ? hi : -1; flash_tile(st, qf, vl + cur, lo - kb - 4 * hl, hie - kb - 4 * hl, lane); }
        if (tb >= kt1) break;
        cur ^= 8192; flash_stage(kB, vB, vl + cur, lane);
        ta = tb; tb = tc; if (tc < kt1) { FR_NEXT(tc); if (tc < kt1) FR_LOAD(kB, vB, tc); }
        { const int kb = ta * 32; const int hie = ((selmask >> (ta >> 1)) & 1u) ? hi : -1; flash_tile(st, qf, vl + cur, lo - kb - 4 * hl, hie - kb - 4 * hl, lane); }
        if (tb >= kt1) break;
        cur ^= 8192; flash_stage(kA, vA, vl + cur, lane);
        ta = tb; tb = tc; if (tc < kt1) { FR_NEXT(tc); if (tc < kt1) FR_LOAD(kA, vA, tc); }
    }
}
#undef FR_NEXT
#undef FR_LOAD
DEV float flash_final(Flash& st) { const float lt = xhalf_sum(st.l); const float inv = lt > 0.f ? 1.f / lt : 0.f;
#pragma unroll
    for (int i = 0; i < 16; ++i) { st.o0[i] *= inv; st.o1[i] *= inv; }
    return lt; }
DEV void store_o(bf16_t* dst  , const f32x16& o0, const f32x16& o1, int hl) {
#pragma unroll
    for (int g = 0; g < 4; ++g) { u32x2 w; w.x = cvt_pk(o0[4 * g], o0[4 * g + 1]); w.y = cvt_pk(o0[4 * g + 2], o0[4 * g + 3]); *(u32x2*)(dst + 8 * g + 4 * hl) = w;
        u32x2 z; z.x = cvt_pk(o1[4 * g], o1[4 * g + 1]); z.y = cvt_pk(o1[4 * g + 2], o1[4 * g + 3]); *(u32x2*)(dst + 32 + 8 * g + 4 * hl) = z; }
}
DEV unsigned wave_pull(unsigned* ctr, int lane) { unsigned v = 0; if (lane == 0) v = __hip_atomic_fetch_add(ctr, 1u, __ATOMIC_RELAXED, __HIP_MEMORY_SCOPE_AGENT); return (unsigned)__builtin_amdgcn_readfirstlane((int)v); }

DEV void dilated_task(const Params& p, int id, LDSP vl, int lane) {
    unsigned char* ws = p.ws; const int l31 = lane & 31, hl = lane >> 5;
    const int j = id & 63, pat = (id >> 6) % 3, bh = id / 192;
    int dil, r, qb;
    if (pat == 0) { dil = 1; r = 0; qb = j; } else if (pat == 1) { dil = 4; r = j >> 4; qb = j & 15; } else { dil = 16; r = j >> 2; qb = j & 3; }
    const bf16_t* Q = (const bf16_t*)(ws + OFF_QA) + (size_t)bh * 2048 * 64 + r * 64;
    const bf16_t* K = (const bf16_t*)(ws + OFF_KA) + (size_t)bh * 2048 * 64 + r * 64;
    const bf16_t* V = (const bf16_t*)(ws + OFF_VA) + (size_t)bh * 2048 * 64 + r * 64;
    const int stride = dil * 64, mq = qb * 32 + l31;
    bf16x8 qf[4];
#pragma unroll
    for (int ks = 0; ks < 4; ++ks) qf[ks] = *(const bf16x8*)(Q + (size_t)mq * stride + ks * 16 + hl * 8);
    Flash st; flash_init(st);
    flash_range(st, qf, K, V, stride, qb >= 4 ? qb - 4 : 0, qb + 1, mq >= 128 ? mq - 128 : 0, mq, 0xffffffffu, vl, lane);
    const float lt = flash_final(st);
    const int b = bh >> 3, h = bh & 7, tok = b * 2048 + mq * dil + r;
    store_o((bf16_t*)(ws + OFF_OP) + ((size_t)pat * T_TOK + tok) * 512 + h * 64, st.o0, st.o1, hl);
    if (hl == 0) __hip_atomic_store((float*)(ws + OFF_LSE) + ((size_t)pat * T_TOK + tok) * 8 + h, st.m + __builtin_log2f(lt), __ATOMIC_RELAXED, __HIP_MEMORY_SCOPE_AGENT);
}

DEV void dilated_pair(const Params& p, int id, LDSP vl, int lane) {
    unsigned char* ws = p.ws; const int l31 = lane & 31, hl = lane >> 5;
    const int j = id & 31, pat = (id >> 5) % 3, bh = id / 96;
    int dil, r, qb;
    if (pat == 0) { dil = 1; r = 0; qb = 2 * j; } else if (pat == 1) { dil = 4; r = j >> 3; qb = 2 * (j & 7); } else { dil = 16; r = j >> 1; qb = 2 * (j & 1); }
    const bf16_t* Q = (const bf16_t*)(ws + OFF_QA) + (size_t)bh * 2048 * 64 + r * 64;
    const bf16_t* K = (const bf16_t*)(ws + OFF_KA) + (size_t)bh * 2048 * 64 + r * 64;
    const bf16_t* V = (const bf16_t*)(ws + OFF_VA) + (size_t)bh * 2048 * 64 + r * 64;
    const int stride = dil * 64, mqA = qb * 32 + l31, mqB = mqA + 32;
    bf16x8 qfA[4], qfB[4];
#pragma unroll
    for (int ks = 0; ks < 4; ++ks) { qfA[ks] = *(const bf16x8*)(Q + (size_t)mqA * stride + ks * 16 + hl * 8); qfB[ks] = *(const bf16x8*)(Q + (size_t)mqB * stride + ks * 16 + hl * 8); }
    Flash sA, sB; flash_init(sA); flash_init(sB);
    const int loA = mqA >= 128 ? mqA - 128 : 0, loB = mqB >= 128 ? mqB - 128 : 0;
    const int kt1 = qb + 2;
    int ta = qb >= 4 ? qb - 4 : 0;
    const bf16_t* kp = K + (size_t)(lane >> 3) * stride + (lane & 7) * 8;
    const bf16_t* vp = V + (size_t)(lane >> 3) * stride + (lane & 7) * 8;
#define DP_LOAD(KR, VR, k) do { _Pragma("unroll") for (int i_ = 0; i_ < 4; ++i_) { KR[i_] = *(const u32x4*)(kp + (size_t)((k) * 32 + 8 * i_) * stride); VR[i_] = *(const u32x4*)(vp + (size_t)((k) * 32 + 8 * i_) * stride); } } while (0)
#define DP_TILE(kt, buf) do { const int kb_ = (kt) * 32; \
        if ((kt) <= qb) flash_tile(sA, qfA, (buf), loA - kb_ - 4 * hl, mqA - kb_ - 4 * hl, lane); \
        if ((kt) >= qb - 3) flash_tile(sB, qfB, (buf), loB - kb_ - 4 * hl, mqB - kb_ - 4 * hl, lane); } while (0)
    u32x4 kA[4], vA[4], kB[4], vB[4];
    DP_LOAD(kA, vA, ta);
    DP_LOAD(kB, vB, ta + 1);
    int cur = 0;
    flash_stage(kA, vA, vl, lane);
    if (ta + 2 < kt1) DP_LOAD(kA, vA, ta + 2);
    for (;;) {
        DP_TILE(ta, vl + cur);
        if (ta + 1 >= kt1) break;
        cur ^= 8192; flash_stage(kB, vB, vl + cur, lane);
        ++ta; if (ta + 2 < kt1) DP_LOAD(kB, vB, ta + 2);
        DP_TILE(ta, vl + cur);
        if (ta + 1 >= kt1) break;
        cur ^= 8192; flash_stage(kA, vA, vl + cur, lane);
        ++ta; if (ta + 2 < kt1) DP_LOAD(kA, vA, ta + 2);
    }
#undef DP_LOAD
#undef DP_TILE
    const int b = bh >> 3, h = bh & 7;
    { const float lt = flash_final(sA); const int tok = b * 2048 + mqA * dil + r;
      store_o((bf16_t*)(ws + OFF_OP) + ((size_t)pat * T_TOK + tok) * 512 + h * 64, sA.o0, sA.o1, hl);
      if (hl == 0) __hip_atomic_store((float*)(ws + OFF_LSE) + ((size_t)pat * T_TOK + tok) * 8 + h, sA.m + __builtin_log2f(lt), __ATOMIC_RELAXED, __HIP_MEMORY_SCOPE_AGENT); }
    { const float lt = flash_final(sB); const int tok = b * 2048 + mqB * dil + r;
      store_o((bf16_t*)(ws + OFF_OP) + ((size_t)pat * T_TOK + tok) * 512 + h * 64, sB.o0, sB.o1, hl);
      if (hl == 0) __hip_atomic_store((float*)(ws + OFF_LSE) + ((size_t)pat * T_TOK + tok) * 8 + h, sB.m + __builtin_log2f(lt), __ATOMIC_RELAXED, __HIP_MEMORY_SCOPE_AGENT); }
}

DEV void merge_tokens(const Params& p, int lane, int wid) {
    unsigned char* ws = p.ws; const bf16_t* OP = (const bf16_t*)(ws + OFF_OP); const float* LSE = (const float*)(ws + OFF_LSE); bf16_t* MIX = (bf16_t*)(ws + OFF_R1);
    const int h = lane >> 3, d0 = (lane & 7) * 8;
    for (int tok = blockIdx.x * 8 + wid; tok < T_TOK; tok += 2048) {
        float l0 = LSE[(size_t)tok * 8 + h], l1 = LSE[((size_t)T_TOK + tok) * 8 + h], l2 = LSE[((size_t)2 * T_TOK + tok) * 8 + h];
        const float mx = fmaxf(l0, fmaxf(l1, l2)); l0 = fexp2(l0 - mx); l1 = fexp2(l1 - mx); l2 = fexp2(l2 - mx); const float inv = 1.f / (l0 + l1 + l2); l0 *= inv; l1 *= inv; l2 *= inv;
        const u32x4 a = *(const u32x4*)(OP + (size_t)tok * 512 + h * 64 + d0), b = *(const u32x4*)(OP + ((size_t)T_TOK + tok) * 512 + h * 64 + d0), c = *(const u32x4*)(OP + ((size_t)2 * T_TOK + tok) * 512 + h * 64 + d0);
        u32x4 w;
#pragma unroll
        for (int i = 0; i < 4; ++i) { const float lo = l0 * bf_lo(a[i]) + l1 * bf_lo(b[i]) + l2 * bf_lo(c[i]), hi = l0 * bf_hi(a[i]) + l1 * bf_hi(b[i]) + l2 * bf_hi(c[i]); w[i] = cvt_pk(lo, hi); }
        *(u32x4*)(MIX + (size_t)tok * 1024 + h * 64 + d0) = w;
    }
}

DEV void nsa_sel_task(const Params& p, int qb, int bg, int lane) {
    unsigned char* ws = p.ws; const int l31 = lane & 31, hl = lane >> 5;
    const int b = bg >> 1, g = bg & 1, t0 = qb * 32, t = t0 + l31, tok = b * 2048 + t;
    const bf16_t* KC = (const bf16_t*)(ws + OFF_KC) + (size_t)bg * 128 * 64; const bf16_t* VC = (const bf16_t*)(ws + OFF_VC) + (size_t)bg * 128 * 64;
    const bf16_t* KS = (const bf16_t*)(ws + OFF_KV6 + 2 * 16 * MB) + (size_t)bg * 2048 * 64; const bf16_t* VS = (const bf16_t*)(ws + OFF_KV6 + 3 * 16 * MB) + (size_t)bg * 2048 * 64;
    const bf16_t* KW = (const bf16_t*)(ws + OFF_KV6 + 4 * 16 * MB) + (size_t)bg * 2048 * 64; const bf16_t* VW = (const bf16_t*)(ws + OFF_KV6 + 5 * 16 * MB) + (size_t)bg * 2048 * 64;
    const bf16_t* QBp = (const bf16_t*)(ws + OFF_QB) + ((size_t)(b * 8 + g * 4) * 2048 + t) * 64 + hl * 8;
    const int cmax = (t >= 31) ? (((t - 31) >> 4) < 126 ? ((t - 31) >> 4) : 126) : -1;
    f32x16 ps[4];
#pragma unroll
    for (int ct = 0; ct < 4; ++ct)
#pragma unroll
        for (int i = 0; i < 16; ++i) ps[ct][i] = 0.f;
#pragma unroll 1
    for (int r = 0; r < 4; ++r) {
        bf16x8 qf[4];
#pragma unroll
        for (int ks = 0; ks < 4; ++ks) qf[ks] = *(const bf16x8*)(QBp + (size_t)r * 2048 * 64 + ks * 16);
        float mx = -INFINITY, sum = 0.f;
#pragma unroll 1
        for (int ct = 0; ct < 4; ++ct) {
            f32x16 sc;
#pragma unroll
            for (int i = 0; i < 16; ++i) sc[i] = 0.f;
#pragma unroll
            for (int ks = 0; ks < 4; ++ks) { const bf16x8 kf = *(const bf16x8*)(KC + (size_t)(ct * 32 + l31) * 64 + ks * 16 + hl * 8); sc = MFMA32(kf, qf[ks], sc); }
            float tm = -INFINITY;
#pragma unroll
            for (int i = 0; i < 16; ++i) { const int c = ct * 32 + (i & 3) + 8 * (i >> 2) + 4 * hl; sc[i] = (c <= cmax) ? sc[i] : -INFINITY; tm = fmaxf(tm, sc[i]); }
            const float mn = fmaxf(mx, tm), ms = (mn == -INFINITY) ? 0.f : mn;
            float rs = 0.f;
#pragma unroll
            for (int i = 0; i < 16; ++i) rs += fexp2(sc[i] - ms);
            sum = sum * fexp2(mx - ms) + rs; mx = mn;
        }
        { const float mo = __shfl_xor(mx, 32), so = __shfl_xor(sum, 32); const float mn = fmaxf(mx, mo), ms = (mn == -INFINITY) ? 0.f : mn;
          sum = sum * fexp2(mx - ms) + so * fexp2(mo - ms); mx = ms; }
        const float inv = sum > 0.f ? 1.f / sum : 0.f;
#pragma unroll
        for (int ct = 0; ct < 4; ++ct) {
            f32x16 sc;
#pragma unroll
            for (int i = 0; i < 16; ++i) sc[i] = 0.f;
#pragma unroll
            for (int ks = 0; ks < 4; ++ks) { const bf16x8 kf = *(const bf16x8*)(KC + (size_t)(ct * 32 + l31) * 64 + ks * 16 + hl * 8); sc = MFMA32(kf, qf[ks], sc); }
#pragma unroll
            for (int i = 0; i < 16; ++i) { const int c = ct * 32 + (i & 3) + 8 * (i >> 2) + 4 * hl; const float e = (c <= cmax) ? fexp2(sc[i] - mx) * inv : 0.f; ps[ct][i] += e; }
        }
    }
    float ie[16], io[16];
    {
        float A[16], Tp[16];
#pragma unroll
        for (int ct = 0; ct < 4; ++ct)
#pragma unroll
            for (int gq = 0; gq < 4; ++gq) { const int jj = ct * 4 + gq; const float p3 = 0.5f * ps[ct][4 * gq + 3]; A[jj] = ps[ct][4 * gq] + ps[ct][4 * gq + 1] + ps[ct][4 * gq + 2] + p3; Tp[jj] = __shfl_xor(p3, 32); }
#pragma unroll
        for (int jj = 0; jj < 16; ++jj) { const float prev = (jj > 0) ? Tp[jj > 0 ? jj - 1 : 0] : 0.f; const float own = A[jj] + (hl ? Tp[jj] : prev); const float oth = __shfl_xor(own, 32);
            ie[jj] = hl ? oth : own; io[jj] = hl ? own : oth; }
    }
    const int blk = t0 >> 6;
    unsigned sel = 1u | (1u << blk) | (blk > 0 ? (1u << (blk - 1)) : 0u);
    {
        const int nforced = blk >= 2 ? 3 : blk + 1, nsel = 8 - nforced, ncand = blk - 2;
        if (ncand > 0) {
            if (ncand <= nsel) sel |= ((1u << (blk - 1)) - 2u);
            else {
#pragma unroll
                for (int jj = 0; jj < 16; ++jj) { const int je = 2 * jj, jo = 2 * jj + 1; ie[jj] = (je >= 1 && je <= blk - 2) ? ie[jj] : -1.f; io[jj] = (jo >= 1 && jo <= blk - 2) ? io[jj] : -1.f; }
                unsigned bits = 0u;
#pragma unroll
                for (int jj = 0; jj < 16; ++jj) {
                    const float cj = hl ? io[jj] : ie[jj]; int cnt = 0;
#pragma unroll
                    for (int j2 = 0; j2 < 16; ++j2) {
                        const bool lte = (j2 < jj) || (j2 == jj && hl);
                        const bool lto = (j2 < jj);
                        cnt += ((ie[j2] > cj) || (ie[j2] == cj && lte)) ? 1 : 0;
                        cnt += ((io[j2] > cj) || (io[j2] == cj && lto)) ? 1 : 0;
                    }
                    if (cj >= 0.f && cnt < nsel) bits |= (1u << (2 * jj)) << hl;
                }
                bits |= (unsigned)__shfl_xor((int)bits, 32);
                sel |= bits;
            }
        }
    }
    if (hl == 0) ((unsigned*)(ws + OFF_SEL))[(size_t)bg * 2048 + t] = sel;
}

DEV void nsa_head_task(const Params& p, int qb, int bg, int r, LDSP vl, int lane) {
    unsigned char* ws = p.ws; const int l31 = lane & 31, hl = lane >> 5;
    const int b = bg >> 1, g = bg & 1, t0 = qb * 32, t = t0 + l31, tok = b * 2048 + t;
    const bf16_t* KC = (const bf16_t*)(ws + OFF_KC) + (size_t)bg * 128 * 64; const bf16_t* VC = (const bf16_t*)(ws + OFF_VC) + (size_t)bg * 128 * 64;
    const bf16_t* KS = (const bf16_t*)(ws + OFF_KV6 + 2 * 16 * MB) + (size_t)bg * 2048 * 64; const bf16_t* VS = (const bf16_t*)(ws + OFF_KV6 + 3 * 16 * MB) + (size_t)bg * 2048 * 64;
    const bf16_t* KW = (const bf16_t*)(ws + OFF_KV6 + 4 * 16 * MB) + (size_t)bg * 2048 * 64; const bf16_t* VW = (const bf16_t*)(ws + OFF_KV6 + 5 * 16 * MB) + (size_t)bg * 2048 * 64;
    const bf16_t* QBp = (const bf16_t*)(ws + OFF_QB) + ((size_t)(b * 8 + g * 4 + r) * 2048 + t) * 64 + hl * 8;
    const int cmax = (t >= 31) ? (((t - 31) >> 4) < 126 ? ((t - 31) >> 4) : 126) : -1;
    const unsigned sel = ((const unsigned*)(ws + OFF_SEL))[(size_t)bg * 2048 + t];
    const float* GT = (const float*)(ws + OFF_GATE) + (size_t)tok * 24 + (g * 4 + r) * 3;
    bf16_t* MIX = (bf16_t*)(ws + OFF_R1) + (size_t)tok * 1024 + 512 + (g * 4 + r) * 64;
    const int wlo = t >= 511 ? t - 511 : 0, wk0 = (t0 >> 5) >= 16 ? (t0 >> 5) - 16 : 0, kend = (t0 >> 5) + 1;
    bf16x8 qf[4];
#pragma unroll
    for (int ks = 0; ks < 4; ++ks) qf[ks] = *(const bf16x8*)(QBp + ks * 16);
    const float g0 = GT[0], g1 = GT[1], g2 = GT[2];
    f32x16 t0a, t1a;
    { Flash st; flash_init(st); flash_range(st, qf, KC, VC, 64, 0, 4, 0, cmax, 0xffffffffu, vl, lane); flash_final(st);
#pragma unroll
      for (int i = 0; i < 16; ++i) { t0a[i] = g0 * st.o0[i]; t1a[i] = g0 * st.o1[i]; } }
    { Flash st; flash_init(st); flash_range(st, qf, KS, VS, 64, 0, kend, 0, t, sel, vl, lane); flash_final(st);
#pragma unroll
      for (int i = 0; i < 16; ++i) { t0a[i] += g1 * st.o0[i]; t1a[i] += g1 * st.o1[i]; } }
    { Flash st; flash_init(st); flash_range(st, qf, KW, VW, 64, wk0, kend, wlo, t, 0xffffffffu, vl, lane); flash_final(st);
#pragma unroll
      for (int i = 0; i < 16; ++i) { t0a[i] += g2 * st.o0[i]; t1a[i] += g2 * st.o1[i]; } }
    store_o(MIX, t0a, t1a, hl);
}

DEV void wg_sync() { asm volatile("s_waitcnt lgkmcnt(0)" ::: "memory"); __builtin_amdgcn_s_barrier(); asm volatile("" ::: "memory"); }
DEV void coop_branch(Flash& st, const bf16x8 (&qf)[4], const bf16_t* kbase, const bf16_t* vbase, int j0, int j1, unsigned blockmask, int lo, int hi, unsigned selmask, LDSP sb, int tid, int lane) {
    const int hl = lane >> 5;
    const int sh = tid >> 8, lt = tid & 255, row = lt >> 3, c = lt & 7;
    const bf16_t* src = (sh ? vbase : kbase) + (size_t)row * 64 + c * 8;
    const int dsto = sh ? ((c >> 2) * 2048 + row * 64 + (c & 3) * 16) : (4096 + row * 128 + ((c ^ ((row >> 1) & 7)) << 4));
#define CB_NEXT(k) do { ++(k); while ((k) < j1 && !((blockmask >> (k)) & 1u)) ++(k); } while (0)
    int ja = j0 - 1; CB_NEXT(ja);
    if (ja >= j1) return;
    u32x4 r0 = *(const u32x4*)(src + (size_t)ja * 64 * 64), r1 = *(const u32x4*)(src + (size_t)(ja * 64 + 32) * 64);
    int jb = ja; CB_NEXT(jb);
    *(LDS u32x4*)(sb + dsto) = r0; *(LDS u32x4*)(sb + 8192 + dsto) = r1;
    if (jb < j1) { r0 = *(const u32x4*)(src + (size_t)jb * 64 * 64); r1 = *(const u32x4*)(src + (size_t)(jb * 64 + 32) * 64); }
    wg_sync();
    int cur = 0;
    for (;;) {
        const int hie = ((selmask >> ja) & 1u) ? hi : -1;
#pragma unroll
        for (int h2 = 0; h2 < 2; ++h2) { const int kb = ja * 64 + h2 * 32;
            if (__any((hie >= kb) && (lo <= kb + 31) && (hie >= lo))) flash_tile(st, qf, sb + cur + h2 * 8192, lo - kb - 4 * hl, hie - kb - 4 * hl, lane); }
        if (jb >= j1) break;
        *(LDS u32x4*)(sb + (cur ^ 16384) + dsto) = r0; *(LDS u32x4*)(sb + (cur ^ 16384) + 8192 + dsto) = r1;
        int jc = jb; CB_NEXT(jc);
        if (jc < j1) { r0 = *(const u32x4*)(src + (size_t)jc * 64 * 64); r1 = *(const u32x4*)(src + (size_t)(jc * 64 + 32) * 64); }
        wg_sync();
        cur ^= 16384; ja = jb; jb = jc;
    }
    wg_sync();
#undef CB_NEXT
}
DEV void nsa_wg_task(const Params& p, int qq, int bg, LDSP lds, int tid, int lane, int wid) {
    unsigned char* ws = p.ws; const int l31 = lane & 31, hl = lane >> 5, r = wid & 3, half = wid >> 2;
    const int b = bg >> 1, g = bg & 1, t0 = qq * 64 + 32 * half, t = t0 + l31, tok = b * 2048 + t;
    const bf16_t* KC = (const bf16_t*)(ws + OFF_KC) + (size_t)bg * 128 * 64; const bf16_t* VC = (const bf16_t*)(ws + OFF_VC) + (size_t)bg * 128 * 64;
    const bf16_t* KS = (const bf16_t*)(ws + OFF_KV6 + 2 * 16 * MB) + (size_t)bg * 2048 * 64; const bf16_t* VS = (const bf16_t*)(ws + OFF_KV6 + 3 * 16 * MB) + (size_t)bg * 2048 * 64;
    const bf16_t* KW = (const bf16_t*)(ws + OFF_KV6 + 4 * 16 * MB) + (size_t)bg * 2048 * 64; const bf16_t* VW = (const bf16_t*)(ws + OFF_KV6 + 5 * 16 * MB) + (size_t)bg * 2048 * 64;
    const bf16_t* QBp = (const bf16_t*)(ws + OFF_QB) + ((size_t)(b * 8 + g * 4 + r) * 2048 + t) * 64 + hl * 8;
    const int cmax = (t >= 31) ? (((t - 31) >> 4) < 126 ? ((t - 31) >> 4) : 126) : -1;
    const unsigned sel = ((const unsigned*)(ws + OFF_SEL))[(size_t)bg * 2048 + t];
    unsigned um = 0u;
#pragma unroll
    for (int j = 0; j < 32; ++j) um |= __any((sel >> j) & 1u) ? (1u << j) : 0u;
    LDS unsigned* xw = (LDS unsigned*)(lds + 32768);
    if (lane == 0) xw[wid] = um;
    wg_sync();
    um = xw[0] | xw[4];
    const float* GT = (const float*)(ws + OFF_GATE) + (size_t)tok * 24 + (g * 4 + r) * 3;
    bf16_t* MIX = (bf16_t*)(ws + OFF_R1) + (size_t)tok * 1024 + 512 + (g * 4 + r) * 64;
    const int wlo = t >= 511 ? t - 511 : 0, jend = qq + 1, wj0 = qq >= 8 ? qq - 8 : 0;
    bf16x8 qf[4];
#pragma unroll
    for (int ks = 0; ks < 4; ++ks) qf[ks] = *(const bf16x8*)(QBp + ks * 16);
    const float g0 = GT[0], g1 = GT[1], g2 = GT[2];
    f32x16 t0a, t1a;
    { Flash st; flash_init(st); coop_branch(st, qf, KC, VC, 0, 2, 0xffffffffu, 0, cmax, 0xffffffffu, lds, tid, lane); flash_final(st);
#pragma unroll
      for (int i = 0; i < 16; ++i) { t0a[i] = g0 * st.o0[i]; t1a[i] = g0 * st.o1[i]; } }
    { Flash st; flash_init(st); coop_branch(st, qf, KS, VS, 0, jend, um, 0, t, sel, lds, tid, lane); flash_final(st);
#pragma unroll
      for (int i = 0; i < 16; ++i) { t0a[i] += g1 * st.o0[i]; t1a[i] += g1 * st.o1[i]; } }
    { Flash st; flash_init(st); coop_branch(st, qf, KW, VW, wj0, jend, 0xffffffffu, wlo, t, 0xffffffffu, lds, tid, lane); flash_final(st);
#pragma unroll
      for (int i = 0; i < 16; ++i) { t0a[i] += g2 * st.o0[i]; t1a[i] += g2 * st.o1[i]; } }
    store_o(MIX, t0a, t1a, hl);
}

DEV void router_wave(const Params& p, int tok0, int lane, int wid, LDSP lds) {
    unsigned char* ws = p.ws; const int l31 = lane & 31, hl = lane >> 5, tok = tok0 + l31;
    const bf16_t* xh = (const bf16_t*)(ws + OFF_X1B) + (size_t)tok * 1024 + hl * 8; const bf16_t* xl = (const bf16_t*)(ws + OFF_X1L) + (size_t)tok * 1024 + hl * 8;
    const bf16_t* WR = (const bf16_t*)(ws + OFF_WRT);
    const int r8 = lane >> 3, slot = lane & 7;
    unsigned wo[3];
#pragma unroll
    for (int i = 0; i < 3; ++i) { const int R = 24 * wid + 8 * i + r8; wo[i] = (unsigned)(R < 96 ? R : R + 32) * 1024u + (unsigned)((slot ^ ((R >> 1) & 7)) << 3); }
    const int dw = wid * 3072;
    const int fbo = l31 * 128, sw = (l31 >> 1) & 7;
    f32x16 acc[3];
#pragma unroll
    for (int a = 0; a < 3; ++a)
#pragma unroll
        for (int i = 0; i < 16; ++i) acc[a][i] = 0.f;
    float ss = 0.f;
    asm volatile("s_waitcnt lgkmcnt(0)" ::: "memory");
    __builtin_amdgcn_s_barrier();
    asm volatile("" ::: "memory");
#pragma unroll
    for (int i = 0; i < 3; ++i) GLDS16(WR + wo[i], dw + i * 1024);
    u32x4 aN[8];
#pragma unroll
    for (int ks = 0; ks < 4; ++ks) { aN[2 * ks] = *(const u32x4*)(xh + ks * 16); aN[2 * ks + 1] = *(const u32x4*)(xl + ks * 16); }
#pragma unroll 1
    for (int kt = 0; kt < 16; ++kt) {
        asm volatile("s_waitcnt vmcnt(0)" ::: "memory");
        __builtin_amdgcn_s_barrier();
        asm volatile("" ::: "memory");
        u32x4 aC[8];
#pragma unroll
        for (int i = 0; i < 8; ++i) aC[i] = aN[i];
        const int cur = (kt & 1) * 24576;
        if (kt + 1 < 16) { const int ko = (kt + 1) * 64;
#pragma unroll
            for (int ks = 0; ks < 4; ++ks) { aN[2 * ks] = *(const u32x4*)(xh + ko + ks * 16); aN[2 * ks + 1] = *(const u32x4*)(xl + ko + ks * 16); }
#pragma unroll
            for (int i = 0; i < 3; ++i) GLDS16(WR + (wo[i] + (unsigned)ko), (24576 - cur) + dw + i * 1024); }
#pragma unroll
        for (int ks = 0; ks < 4; ++ks) {
            const u32x4 ahu = aC[2 * ks], alu = aC[2 * ks + 1];
#pragma unroll
            for (int i = 0; i < 4; ++i) { const float a = bf_lo(ahu[i]) + bf_lo(alu[i]), c = bf_hi(ahu[i]) + bf_hi(alu[i]); ss += a * a + c * c; }
            const bf16x8 ah = __builtin_bit_cast(bf16x8, ahu), al = __builtin_bit_cast(bf16x8, alu);
            const int ch = ((2 * ks + hl) ^ sw) << 4;
#pragma unroll
            for (int gr = 0; gr < 3; ++gr) { const bf16x8 bh = *(const LDS bf16x8*)(lds + cur + gr * 4096 + fbo + ch), bl = *(const LDS bf16x8*)(lds + cur + 12288 + gr * 4096 + fbo + ch);
                acc[gr] = MFMA32(bh, ah, acc[gr]); acc[gr] = MFMA32(bh, al, acc[gr]); acc[gr] = MFMA32(bl, ah, acc[gr]); }
        }
    }
    ss += __shfl_xor(ss, 32);
    const float rstd = 1.0f / sqrtf(ss * (1.0f / 1024.0f) + EPSN);
    int gs = 0; float pg;
    { float lg[8], mx = -INFINITY;
#pragma unroll
      for (int i = 0; i < 8; ++i) { lg[i] = acc[0][i] * rstd + p.b_rg[i]; if (lg[i] > mx) { mx = lg[i]; gs = i; } }
      float z = 0.f;
#pragma unroll
      for (int i = 0; i < 8; ++i) z += __expf(lg[i] - mx);
      pg = 1.f / z; }
    { const int go = __shfl_xor(gs, 32); const float po = __shfl_xor(pg, 32); if (hl) { gs = go; pg = po; } }
    const int ci = gs >> 1;
    float el[8];
#pragma unroll
    for (int k = 0; k < 8; ++k) {
        const float h1 = ci == 0 ? acc[0][k] : ci == 1 ? acc[0][8 + k] : ci == 2 ? acc[1][k] : acc[1][8 + k];
        const float h0 = ci == 0 ? acc[0][8 + k] : ci == 1 ? acc[1][k] : ci == 2 ? acc[1][8 + k] : acc[2][k];
        el[k] = (hl ? h1 : h0) * rstd + p.b_re[gs * 8 + k];
    }
    if (hl == 1 - (gs & 1)) {
        int i1 = 0; float m1 = -INFINITY;
#pragma unroll
        for (int k = 0; k < 8; ++k) if (el[k] > m1) { m1 = el[k]; i1 = k; }
        int i2 = 0; float m2 = -INFINITY;
#pragma unroll
        for (int k = 0; k < 8; ++k) if (k != i1 && el[k] > m2) { m2 = el[k]; i2 = k; }
        const float e2 = __expf(m2 - m1), w1 = pg / (1.f + e2), w2 = pg * e2 / (1.f + e2);
        const int ex1 = gs * 8 + i1, ex2 = gs * 8 + i2;
        unsigned* cnt = (unsigned*)(ws + OFF_CNT); unsigned* LIST = (unsigned*)(ws + OFF_LIST);
        const unsigned p1 = __hip_atomic_fetch_add(cnt + ex1, 1u, __ATOMIC_RELAXED, __HIP_MEMORY_SCOPE_AGENT);
        const unsigned p2 = __hip_atomic_fetch_add(cnt + ex2, 1u, __ATOMIC_RELAXED, __HIP_MEMORY_SCOPE_AGENT);
        __hip_atomic_store(LIST + (size_t)ex1 * 65536 + p1, (unsigned)tok * 2u, __ATOMIC_RELAXED, __HIP_MEMORY_SCOPE_AGENT);
        __hip_atomic_store(LIST + (size_t)ex2 * 65536 + p2, (unsigned)tok * 2u + 1u, __ATOMIC_RELAXED, __HIP_MEMORY_SCOPE_AGENT);
        int* TE = (int*)(ws + OFF_TE); int* TP = (int*)(ws + OFF_TP); float* TW = (float*)(ws + OFF_TW);
        TE[tok * 2] = ex1; TE[tok * 2 + 1] = ex2; TP[tok * 2] = (int)p1; TP[tok * 2 + 1] = (int)p2; TW[tok * 2] = w1; TW[tok * 2 + 1] = w2;
        ((float*)(ws + OFF_RSTD2))[tok] = rstd;
    }
}

DEV void build_tb(const Params& p, LDS int* tb) {
    if (threadIdx.x == 0) { const unsigned* cnt = (const unsigned*)(p.ws + OFF_CNT); int a = 0;
        for (int e = 0; e < 64; ++e) { tb[e] = a; const int n = (int)((cnt[e] + 255u) >> 8); for (int t = 0; t < n; ++t) tb[128 + a + t] = e; a += n; }
        tb[64] = a; }
    __syncthreads();
}

extern __shared__ __attribute__((aligned(16))) unsigned char smem_raw[];
__global__ void __launch_bounds__(512, 2) hymba_fwd(Params p) {
    __shared__ uint4 xb_words;
    if (threadIdx.x == 0) xb_words = make_uint4(0u, 0u, 0u, 0u);
    __syncthreads();
    unsigned char* ws = p.ws;
    (void)xcd_barrier_post((unsigned*)(ws + OFF_BAR), (volatile LAS unsigned*)&xb_words);
#if DBG_XBAR
#define GRID_BAR() do { xcd_barrier((unsigned*)(p.ws + OFF_BAR), (volatile LAS unsigned*)&xb_words); xcd_barrier((unsigned*)(p.ws + OFF_BAR), (volatile LAS unsigned*)&xb_words); } while (0)
#else
#define GRID_BAR() xcd_barrier((unsigned*)(p.ws + OFF_BAR), (volatile LAS unsigned*)&xb_words)
#endif
    LDSP lds = (LDSP)smem_raw;
    const int bid = blockIdx.x, xcd = bid & 7, ci = bid >> 3;
#define PHASE_IDS const int tid = opaque((int)threadIdx.x), lane = tid & 63, wid = __builtin_amdgcn_readfirstlane(tid >> 6); LDSP vl = lds + wid * 16384; (void)lane; (void)vl;

#if SKEL < 2
    REPS(0) if (!SKEL) p0_prologue(p, lds);
    GRID_BAR();

    REPS(1) if (!SKEL) {
        const OrderXcd S{(const char*)(ws + OFF_R1), (const char*)(ws + OFF_WINT), (size_t)256 * 1024 * 2, (size_t)256 * 1024 * 2, 12, 12, xcd, ci};
        pg::gemm_phase<EpiInProj, OrderXcd, true, false>(lds, 1024, 1024, S, EpiInProj{ws});
    }
    GRID_BAR();

    REPS(20) if (!SKEL && bid < 64) {
        const int kv = bid & 1, mt = bid >> 1;
        { OrderOne S{}; S.u.a = (const char*)(ws + OFF_KV6 + (size_t)kv * 16 * MB) + (size_t)mt * 256 * 1024 * 2; S.u.b = (const char*)(ws + OFF_WC1T) + (size_t)kv * 256 * 2048 * 2; S.u.pm = mt; S.u.pn = 0; S.u.x0 = 0; S.u.x1 = 0; S.u.x2 = 0;
          pg::gemm_phase<EpiCmp1, OrderOne, false, false>(lds, 2048, 1024, S, EpiCmp1{ws, kv}); }
        asm volatile("s_waitcnt vmcnt(0)" ::: "memory");
        __syncthreads();
        { OrderOne S{}; S.u.a = (const char*)(ws + OFF_HID) + ((size_t)kv * 8192 + (size_t)mt * 256) * 256 * 2; S.u.b = (const char*)(ws + OFF_WC2T) + (size_t)kv * 256 * 256 * 2; S.u.pm = mt; S.u.pn = 0; S.u.x0 = 0; S.u.x1 = 0; S.u.x2 = 0;
          pg::gemm_phase<EpiCmp2, OrderOne, false, false>(lds, 256, 256, S, EpiCmp2{ws, kv}); }
    }
#if EN_DIL
    REPS(2) if (!SKEL) { PHASE_IDS
        unsigned* qbase = (unsigned*)(ws + OFF_QUEUE) + 512 * rep_;
        const int x0 = (int)xb_xcc_id() & 7;
        for (int dq = 0; dq < 8; ++dq) { const int x = (x0 + dq) & 7; unsigned* ctr = qbase + x * 16;
            for (;;) { const unsigned t = wave_pull(ctr, lane); if (t >= 3072u) break; dilated_pair(p, x * 3072 + (int)t, vl, opaque(lane)); } }
    }
#endif
    GRID_BAR();

    if (!SKEL) { PHASE_IDS
#if EN_DIL
    merge_tokens(p, lane, wid);
#else
    for (int tok = bid * 8 + wid; tok < T_TOK; tok += 2048) *(u32x4*)((bf16_t*)(ws + OFF_R1) + (size_t)tok * 1024 + lane * 8) = (u32x4){0u, 0u, 0u, 0u};
#endif
    }
    REPS(3) if (!SKEL) { PHASE_IDS
#if EN_NSA
        const int x0 = (int)xb_xcc_id() & 7;
        { unsigned* qbase = (unsigned*)(ws + OFF_QUEUE) + 384;
          for (int dq = 0; dq < 8; ++dq) { const int x = (x0 + dq) & 7; unsigned* ctr = qbase + x * 16;
            for (;;) { const unsigned t = wave_pull(ctr, lane); if (t >= 512u) break; nsa_sel_task(p, 63 - (int)(t & 63u), 8 * x + (int)(t >> 6), opaque(lane)); } } }
        GRID_BAR();
        { unsigned* qbase = (unsigned*)(ws + OFF_QUEUE) + 256 + 512 * rep_;
          LDS unsigned* tw = (LDS unsigned*)(lds + 32768 + 64);
          for (int dq = 0; dq < 8; ++dq) { const int x = (x0 + dq) & 7; unsigned* ctr = qbase + x * 16;
            for (;;) { if (tid == 0) tw[0] = __hip_atomic_fetch_add(ctr, 1u, __ATOMIC_RELAXED, __HIP_MEMORY_SCOPE_AGENT);
                wg_sync(); const unsigned t = tw[0]; wg_sync();
                if (t >= 256u) break;
                nsa_wg_task(p, 31 - (int)(t & 31u), 8 * x + (int)(t >> 5), lds, tid, opaque(lane), wid); } } }
#else
    for (int tok = bid * 8 + wid; tok < T_TOK; tok += 2048) *(u32x4*)((bf16_t*)(ws + OFF_R1) + (size_t)tok * 1024 + 512 + lane * 8) = (u32x4){0u, 0u, 0u, 0u};
#endif
    }
    GRID_BAR();

    REPS(4) if (!SKEL) {
        const OrderXcd S{(const char*)(ws + OFF_R1), (const char*)(ws + OFF_WOT), (size_t)256 * 1024 * 2, (size_t)256 * 1024 * 2, 4, 4, xcd, ci};
        pg::gemm_phase<EpiOut, OrderXcd, true, false>(lds, 1024, 1024, S, EpiOut{ws, p.x});
    }
    GRID_BAR();

#endif
    LDS int* tb = (LDS int*)(lds + LDS_TB); (void)tb;
#if EN_MOE && !SKEL
    { PHASE_IDS
    router_wave(p, (bid * 8 + wid) * 32, lane, wid, lds); }
    GRID_BAR();

    build_tb(p, tb);
    REPS(6) {
        const OrderMoe1 S{(const char*)(ws + OFF_X1B), (const char*)(ws + OFF_WGUT), (const unsigned*)(ws + OFF_LIST), (const unsigned*)(ws + OFF_CNT), (LDS const int*)tb, tb[64], bid};
#ifndef NO_P6
        pg::gemm_phase<EpiMoe1, OrderMoe1, true, true>(lds, 1024, 1024, S, EpiMoe1{ws});
#endif
    }
    GRID_BAR();

    REPS(7) {
        const OrderMoe2 S{(const char*)(ws + OFF_HE), (const char*)(ws + OFF_WDT), (LDS const int*)tb, tb[64], bid};
#ifndef NO_P7
        pg::gemm_phase<EpiMoe2, OrderMoe2, true, false>(lds, 256, 256, S, EpiMoe2{ws});
#endif
    }
    GRID_BAR();
#endif

    REPS(8) { PHASE_IDS
        const bf16_t* XB = (const bf16_t*)(ws + OFF_X1B); const bf16_t* Y = (const bf16_t*)(ws + OFF_Y);
        const int* TE = (const int*)(ws + OFF_TE); const int* TP = (const int*)(ws + OFF_TP); const float* TW = (const float*)(ws + OFF_TW);
        f32x4 gf[4];
#pragma unroll
        for (int i = 0; i < 4; ++i) gf[i] = *(const f32x4*)(p.norm_f_g + i * 256 + lane * 4);
        int tok = bid * 8 + wid;
        u32x2 te[2], tp[2]; f32x2 tw[2];
#pragma unroll
        for (int j = 0; j < 2; ++j) { const int t = tok + 2048 * j; te[j] = *(const u32x2*)(TE + t * 2); tp[j] = *(const u32x2*)(TP + t * 2); tw[j] = *(const f32x2*)(TW + t * 2); }
        for (; tok < T_TOK; tok += 4096) {
            u32x2 xa[2][4], ya[2][4], yb[2][4];
#pragma unroll
            for (int j = 0; j < 2; ++j) { const int t = tok + 2048 * j;
                const bf16_t* y0 = Y + (size_t)(tb[te[j].x] * 256 + (int)tp[j].x) * 1024; const bf16_t* y1 = Y + (size_t)(tb[te[j].y] * 256 + (int)tp[j].y) * 1024;
#pragma unroll
                for (int i = 0; i < 4; ++i) { const int c = i * 256 + lane * 4; xa[j][i] = *(const u32x2*)(XB + (size_t)t * 1024 + c); ya[j][i] = *(const u32x2*)(y0 + c); yb[j][i] = *(const u32x2*)(y1 + c); } }
            f32x2 twc[2] = {tw[0], tw[1]};
            { const int tn = tok + 4096 < T_TOK ? tok + 4096 : tok;
#pragma unroll
              for (int j = 0; j < 2; ++j) { const int t = tn + 2048 * j; te[j] = *(const u32x2*)(TE + t * 2); tp[j] = *(const u32x2*)(TP + t * 2); tw[j] = *(const f32x2*)(TW + t * 2); } }
#pragma unroll
            for (int j = 0; j < 2; ++j) { const int t = tok + 2048 * j; const float w0 = twc[j].x, w1 = twc[j].y;
                float v[16]; float ss = 0.f;
#pragma unroll
                for (int i = 0; i < 4; ++i) {
                    v[4 * i] = bf_lo(xa[j][i].x) + w0 * bf_lo(ya[j][i].x) + w1 * bf_lo(yb[j][i].x); v[4 * i + 1] = bf_hi(xa[j][i].x) + w0 * bf_hi(ya[j][i].x) + w1 * bf_hi(yb[j][i].x);
                    v[4 * i + 2] = bf_lo(xa[j][i].y) + w0 * bf_lo(ya[j][i].y) + w1 * bf_lo(yb[j][i].y); v[4 * i + 3] = bf_hi(xa[j][i].y) + w0 * bf_hi(ya[j][i].y) + w1 * bf_hi(yb[j][i].y);
                    ss += v[4 * i] * v[4 * i] + v[4 * i + 1] * v[4 * i + 1] + v[4 * i + 2] * v[4 * i + 2] + v[4 * i + 3] * v[4 * i + 3]; }
#pragma unroll
                for (int o = 32; o > 0; o >>= 1) ss += __shfl_xor(ss, o);
                const float rs = 1.0f / sqrtf(ss * (1.0f / 1024.0f) + EPSN);
#pragma unroll
                for (int i = 0; i < 4; ++i) { const int c = i * 256 + lane * 4;
                    f32x4 o; o[0] = v[4 * i] * rs * gf[i][0]; o[1] = v[4 * i + 1] * rs * gf[i][1]; o[2] = v[4 * i + 2] * rs * gf[i][2]; o[3] = v[4 * i + 3] * rs * gf[i][3];
                    *(f32x4*)(p.out + (size_t)t * 1024 + c) = o; } }
        }
    }
}

extern "C" void kernel_launch(void* const* d_in, const int* in_sizes, int n_in, void* d_out, int out_size, void* d_ws, size_t ws_size, hipStream_t stream) {
    static int grid = 0;
    if (grid == 0) {
        int dev = 0, cus = 0;
        if (hipGetDevice(&dev) != hipSuccess || hipDeviceGetAttribute(&cus, hipDeviceAttributeMultiprocessorCount, dev) != hipSuccess) { grid = -1; return; }
        if (hipFuncSetAttribute((const void*)hymba_fwd, hipFuncAttributeMaxDynamicSharedMemorySize, LDS_TOTAL) != hipSuccess) { grid = -1; return; }
        int per_cu = 0;
        (void)hipOccupancyMaxActiveBlocksPerMultiprocessor(&per_cu, (const void*)hymba_fwd, 512, LDS_TOTAL);
        (void)hipGetLastError();
        grid = cus < 256 ? cus : 256;
    }
    if (grid < 0) return;
    (void)hipMemsetAsync(d_ws, 0, CTL_ZERO, stream);
    Params p{};
    p.x = (const float*)d_in[0]; p.norm1_g = (const float*)d_in[1]; p.w_in = (const float*)d_in[2]; p.pe_kc = (const float*)d_in[3]; p.w_kc1 = (const float*)d_in[4]; p.w_kc2 = (const float*)d_in[5];
    p.pe_vc = (const float*)d_in[6]; p.w_vc1 = (const float*)d_in[7]; p.w_vc2 = (const float*)d_in[8]; p.w_o = (const float*)d_in[9]; p.norm2_g = (const float*)d_in[10];
    p.w_rg = (const float*)d_in[11]; p.b_rg = (const float*)d_in[12]; p.w_re = (const float*)d_in[13]; p.b_re = (const float*)d_in[14]; p.w_gate = (const float*)d_in[15]; p.w_up = (const float*)d_in[16]; p.w_down = (const float*)d_in[17]; p.norm_f_g = (const float*)d_in[18];
    p.out = (float*)d_out; p.ws = (unsigned char*)d_ws;
    hipLaunchKernelGGL(hymba_fwd, dim3(grid), dim3(512), LDS_TOTAL, stream, p);
}
```
